# Optimizing an MI355X kernel written in HIP

```python
import jax, jax.numpy as jnp
from jax import lax
import numpy as np

D_MODEL = 1024
BATCH = 16
SEQ = 2048
DEPTH = 1
DEC_BATCH = 8
DEC_SEQ = 2048
PAST_LEN = 128

GRID_W = 64
N_MEM = 256
EPS = 1e-6
GLA_HEADS = 4
GLA_DK = D_MODEL // 2 // GLA_HEADS
GLA_DV = D_MODEL // GLA_HEADS
GLA_QK = GLA_HEADS * GLA_DK
GLA_V = GLA_HEADS * GLA_DV
GLA_RANK = 16
GLA_TAU = 16.0
GLA_CHUNK = 64
ATT_HEADS = 8
ATT_KV_HEADS = 2
ATT_HD = 128
ATT_Q = ATT_HEADS * ATT_HD
ATT_KV = ATT_KV_HEADS * ATT_HD
ROPE_THETA = 10000.0
Q_BLOCK = 128
X_HEADS = 4
X_HD = D_MODEL // X_HEADS
D_FF = ((8 * D_MODEL + 3 * 256 - 1) // (3 * 256)) * 256
IN_SPLITS = (GLA_QK, GLA_QK, GLA_V, GLA_V, GLA_RANK, GLA_RANK, ATT_Q, ATT_KV, ATT_KV, D_MODEL, D_MODEL)
D_IN = sum(IN_SPLITS)

kernel_name = "hybrid_gla_gqa_axial_encoder"


def rmsnorm(x, w):
    xf = x.astype(jnp.float32)
    y = xf * lax.rsqrt(jnp.mean(xf * xf, axis=-1, keepdims=True) + EPS) * w.astype(jnp.float32)
    return y.astype(x.dtype)


def gla_chunked(q, k, v, g, strict):
    B, H, T, dk = q.shape
    dv = v.shape[-1]
    C = GLA_CHUNK
    N = T // C
    q = q.reshape(B, H, N, C, dk)
    k = k.reshape(B, H, N, C, dk)
    v = v.reshape(B, H, N, C, dv)
    b = jnp.cumsum(g.reshape(B, H, N, C, dk), axis=3)
    b_last = b[:, :, :, -1:, :]
    qg = q * jnp.exp(b)
    kg = k * jnp.exp(-b)
    k_end = k * jnp.exp(b_last - b)
    mask = jnp.tril(jnp.ones((C, C), dtype=bool), k=-1 if strict else 0)
    a = jnp.where(mask, jnp.einsum('bhnid,bhnjd->bhnij', qg, kg), 0.0)
    o_intra = jnp.einsum('bhnij,bhnje->bhnie', a, v)

    def step(S, inp):
        qg_n, kend_n, v_n, dec_n = inp
        o_n = jnp.einsum('bhid,bhde->bhie', qg_n, S)
        S = dec_n[..., None] * S + jnp.einsum('bhjd,bhje->bhde', kend_n, v_n)
        return S, o_n

    xs = (jnp.moveaxis(qg, 2, 0), jnp.moveaxis(k_end, 2, 0), jnp.moveaxis(v, 2, 0),
          jnp.moveaxis(jnp.exp(b_last[:, :, :, 0, :]), 2, 0))
    S0 = jnp.zeros((B, H, dk, dv), q.dtype)
    _, o_inter = lax.scan(step, S0, xs)
    o = o_intra + jnp.moveaxis(o_inter, 0, 2)
    return o.reshape(B, H, T, dv)


def gla_branch(q, k, v, r, zf, zb, wa_f, ba_f, wa_b, ba_b, gnorm):
    B, T, _ = q.shape
    f32 = jnp.float32

    def heads(t, d):
        return t.astype(f32).reshape(B, T, GLA_HEADS, d).transpose(0, 2, 1, 3)

    qh = heads(q, GLA_DK) * (GLA_DK ** -0.5)
    kh = heads(k, GLA_DK)
    vh = heads(v, GLA_DV)
    gf = heads(jax.nn.log_sigmoid(zf.astype(f32) @ wa_f.astype(f32) + ba_f.astype(f32)) / GLA_TAU, GLA_DK)
    gb = heads(jax.nn.log_sigmoid(zb.astype(f32) @ wa_b.astype(f32) + ba_b.astype(f32)) / GLA_TAU, GLA_DK)
    flip = lambda t: jnp.flip(t, axis=2)
    o_fwd = gla_chunked(qh, kh, vh, gf, False)
    o_bwd = flip(gla_chunked(flip(qh), flip(kh), flip(vh), flip(gb), True))
    o = rmsnorm(o_fwd + o_bwd, gnorm)
    o = o.transpose(0, 2, 1, 3).reshape(B, T, GLA_V)
    return (o * jax.nn.silu(r.astype(f32))).astype(q.dtype)


def axial_rope_tables(T):
    rows = T // GRID_W
    row = jnp.broadcast_to(jnp.arange(rows)[:, None], (rows, GRID_W)).reshape(-1).astype(jnp.float32)
    col = jnp.broadcast_to(jnp.arange(GRID_W)[None, :], (rows, GRID_W)).reshape(-1).astype(jnp.float32)
    half = ATT_HD // 2
    inv_freq = ROPE_THETA ** (-jnp.arange(0, half, 2, dtype=jnp.float32) / half)
    ang_r = row[:, None] * inv_freq[None, :]
    ang_c = col[:, None] * inv_freq[None, :]
    return jnp.cos(ang_r), jnp.sin(ang_r), jnp.cos(ang_c), jnp.sin(ang_c)


def rotate(x, cos, sin):
    shape = (cos.shape[0],) + (1,) * (x.ndim - 3) + (cos.shape[-1],)
    cos = cos.reshape(shape)
    sin = sin.reshape(shape)
    x1, x2 = jnp.split(x, 2, axis=-1)
    return jnp.concatenate([x1 * cos - x2 * sin, x2 * cos + x1 * sin], axis=-1)


def apply_axial_rope(x, tables):
    cr, sr, cc, sc = tables
    xr, xc = jnp.split(x, 2, axis=-1)
    return jnp.concatenate([rotate(xr, cr, sr), rotate(xc, cc, sc)], axis=-1)


def gqa_branch(q, k, v, q_norm, k_norm):
    B, T, _ = q.shape
    G = ATT_HEADS // ATT_KV_HEADS
    f32 = jnp.float32
    qh = rmsnorm(q.astype(f32).reshape(B, T, ATT_KV_HEADS, G, ATT_HD), q_norm)
    kh = rmsnorm(k.astype(f32).reshape(B, T, ATT_KV_HEADS, ATT_HD), k_norm)
    vh = v.astype(f32).reshape(B, T, ATT_KV_HEADS, ATT_HD)
    tables = axial_rope_tables(T)
    qh = apply_axial_rope(qh, tables) * (ATT_HD ** -0.5)
    kh = apply_axial_rope(kh, tables)
    qb = qh.reshape(B, T // Q_BLOCK, Q_BLOCK, ATT_KV_HEADS, G, ATT_HD).transpose(1, 0, 2, 3, 4, 5)

    def block(qi):
        s = jnp.einsum('bqkgd,bskd->bkgqs', qi, kh)
        p = jax.nn.softmax(s, axis=-1)
        return jnp.einsum('bkgqs,bskd->bqkgd', p, vh)

    o = lax.map(block, qb)
    o = o.transpose(1, 0, 2, 3, 4, 5).reshape(B, T, ATT_Q)
    return o.astype(q.dtype)


def cross_attn(h, m, wq, wkv, wo):
    B, T, _ = h.shape
    M = m.shape[1]
    f32 = jnp.float32
    q = (h @ wq).astype(f32).reshape(B, T, X_HEADS, X_HD) * (X_HD ** -0.5)
    k, v = jnp.split((m @ wkv).astype(f32), 2, axis=-1)
    k = k.reshape(B, M, X_HEADS, X_HD)
    v = v.reshape(B, M, X_HEADS, X_HD)
    p = jax.nn.softmax(jnp.einsum('bthd,bmhd->bhtm', q, k), axis=-1)
    o = jnp.einsum('bhtm,bmhd->bthd', p, v).reshape(B, T, D_MODEL)
    return o.astype(h.dtype) @ wo


def encoder_layer(x, mem, ln_mix_pre, w_in, gla_wa_f, gla_ba_f, gla_wa_b, gla_ba_b, gla_norm,
                  att_q_norm, att_k_norm, w_branch_gla, w_branch_att, w_out, ln_mix_post,
                  ln_x_pre, ln_mem, x_wq, x_wkv, x_wo, ln_x_post,
                  ln_ffn_pre, ffn_wi, ffn_wo, ln_ffn_post):
    h = rmsnorm(x, ln_mix_pre)
    proj = h @ w_in
    split_idx = np.cumsum(IN_SPLITS)[:-1].tolist()
    gq, gk, gv, gr, zf, zb, aq, ak, av, gate_a, gate_b = jnp.split(proj, split_idx, axis=-1)
    out_a = gla_branch(gq, gk, gv, gr, zf, zb, gla_wa_f, gla_ba_f, gla_wa_b, gla_ba_b, gla_norm) @ w_branch_gla
    out_b = gqa_branch(aq, ak, av, att_q_norm, att_k_norm) @ w_branch_att
    mixed = jax.nn.sigmoid(gate_a) * out_a + jax.nn.sigmoid(gate_b) * out_b
    x = x + rmsnorm(mixed @ w_out, ln_mix_post)
    h = rmsnorm(x, ln_x_pre)
    m = rmsnorm(mem, ln_mem)
    x = x + rmsnorm(cross_attn(h, m, x_wq, x_wkv, x_wo), ln_x_post)
    h = rmsnorm(x, ln_ffn_pre)
    g, u = jnp.split(h @ ffn_wi, 2, axis=-1)
    x = x + rmsnorm((jax.nn.silu(g) * u) @ ffn_wo, ln_ffn_post)
    return x


def setup_inputs(seed: int = 0) -> dict:
    key = jax.random.key(seed)
    ks = iter(jax.random.split(key, 40))
    f32 = jnp.float32

    def w(shape, fan_in):
        return jax.random.normal(next(ks), (DEPTH,) + shape, f32) * (fan_in ** -0.5)

    def gain(n):
        return 1.0 + 0.05 * jax.random.normal(next(ks), (DEPTH, n), f32)

    def bias(n):
        return 0.01 * jax.random.normal(next(ks), (DEPTH, n), f32)

    return {
        "x_prompt": jax.random.normal(next(ks), (BATCH, SEQ, D_MODEL), f32),
        "x_sample": jax.random.normal(next(ks), (DEC_BATCH, DEC_SEQ, D_MODEL), f32),
        "mem_prompt": jax.random.normal(next(ks), (BATCH, N_MEM, D_MODEL), f32),
        "mem_sample": jax.random.normal(next(ks), (DEC_BATCH, N_MEM, D_MODEL), f32),
        "ln_mix_pre": gain(D_MODEL),
        "w_in": w((D_MODEL, D_IN), D_MODEL),
        "gla_wa_f": w((GLA_RANK, GLA_QK), GLA_RANK),
        "gla_ba_f": bias(GLA_QK),
        "gla_wa_b": w((GLA_RANK, GLA_QK), GLA_RANK),
        "gla_ba_b": bias(GLA_QK),
        "gla_norm": gain(GLA_DV),
        "att_q_norm": gain(ATT_HD),
        "att_k_norm": gain(ATT_HD),
        "w_branch_gla": w((GLA_V, D_MODEL), GLA_V),
        "w_branch_att": w((ATT_Q, D_MODEL), ATT_Q),
        "w_out": w((D_MODEL, D_MODEL), D_MODEL),
        "ln_mix_post": gain(D_MODEL),
        "ln_x_pre": gain(D_MODEL),
        "ln_mem": gain(D_MODEL),
        "x_wq": w((D_MODEL, D_MODEL), D_MODEL),
        "x_wkv": w((D_MODEL, 2 * D_MODEL), D_MODEL),
        "x_wo": w((D_MODEL, D_MODEL), D_MODEL),
        "ln_x_post": gain(D_MODEL),
        "ln_ffn_pre": gain(D_MODEL),
        "ffn_wi": w((D_MODEL, 2 * D_FF), D_MODEL),
        "ffn_wo": w((D_FF, D_MODEL), D_FF),
        "ln_ffn_post": gain(D_MODEL),
    }


def reference(x_prompt, x_sample, mem_prompt, mem_sample, ln_mix_pre, w_in, gla_wa_f, gla_ba_f,
              gla_wa_b, gla_ba_b, gla_norm, att_q_norm, att_k_norm, w_branch_gla, w_branch_att,
              w_out, ln_mix_post, ln_x_pre, ln_mem, x_wq, x_wkv, x_wo, ln_x_post,
              ln_ffn_pre, ffn_wi, ffn_wo, ln_ffn_post):
    params = (ln_mix_pre, w_in, gla_wa_f, gla_ba_f, gla_wa_b, gla_ba_b, gla_norm,
              att_q_norm, att_k_norm, w_branch_gla, w_branch_att, w_out, ln_mix_post,
              ln_x_pre, ln_mem, x_wq, x_wkv, x_wo, ln_x_post,
              ln_ffn_pre, ffn_wi, ffn_wo, ln_ffn_post)
    y_prompt = x_prompt
    y_sample = x_sample
    for l in range(DEPTH):
        lp = [p[l] for p in params]
        y_prompt = encoder_layer(y_prompt, mem_prompt, *lp)
        y_sample = encoder_layer(y_sample, mem_sample, *lp)
    return (y_prompt, y_sample)
```

```cpp
#include <hip/hip_runtime.h>
#include <hip/hip_cooperative_groups.h>
#include <cstdio>
#include <cstdint>
namespace cg = cooperative_groups;

#define LAS __attribute__((address_space(3)))
typedef unsigned short bf16_t;
typedef short bf16x8 __attribute__((ext_vector_type(8)));
typedef float f32x2 __attribute__((ext_vector_type(2)));
typedef float f32x4 __attribute__((ext_vector_type(4)));
typedef float f32x16 __attribute__((ext_vector_type(16)));
typedef unsigned u32x2 __attribute__((ext_vector_type(2)));
typedef unsigned u32x4 __attribute__((ext_vector_type(4)));
typedef __bf16 bf16v2 __attribute__((ext_vector_type(2)));
#define DI __device__ __forceinline__
#define MFMA32(a, b, c) __builtin_amdgcn_mfma_f32_32x32x16_bf16((a), (b), (c), 0, 0, 0)

DI unsigned pk2(float lo, float hi) { f32x2 v = {lo, hi}; bf16v2 r = __builtin_convertvector(v, bf16v2); return __builtin_bit_cast(unsigned, r); }
DI bf16_t f2bf(float f) { return (bf16_t)(pk2(f, 0.f) & 0xffffu); }
DI float bf_lo(unsigned u) { return __uint_as_float(u << 16); }
DI float bf_hi(unsigned u) { return __uint_as_float(u & 0xffff0000u); }
DI float bf2f(bf16_t v) { return __uint_as_float(((unsigned)v) << 16); }
DI float sigmoidf_(float v) { return __builtin_amdgcn_rcpf(1.f + __expf(-v)); }
DI int tid_opaque() { int t = threadIdx.x; asm volatile("" : "+v"(t)); return t; }
DI int crow(int r, int hi) { return (r & 3) + 8 * (r >> 2) + 4 * hi; }
DI float wave_sum(float v) {
#pragma unroll
    for (int o = 1; o < 64; o <<= 1) v += __shfl_xor(v, o);
    return v;
}

constexpr int DM = 1024, NBATCH = 24, T = 2048, MTOT = NBATCH * T, RB = 8, MR = RB * T, NROUND = 3, NMEM = 256, MMEM = NBATCH * NMEM;
constexpr int DFF = 2816;
constexpr int LDP = 3840;
constexpr int PC_GQ = 0, PC_GK = 512, PC_GR = 1024, PC_AQ = 2048, PC_AK = 3072, PC_AV = 3328, PC_Z = 3584;
constexpr int NPROJ_TILES = 15, N1 = 23 * 256;
constexpr float EPS = 1e-6f;
constexpr size_t MiB = 1u << 20;
constexpr size_t WS_CTL = 0;
constexpr size_t WS_WIN = 1 * MiB;
constexpr size_t WS_WGV = WS_WIN + (size_t)N1 * 1024 * 2;
constexpr size_t WS_WA = WS_WGV + 2 * MiB, WS_WB = WS_WA + 2 * MiB, WS_WOUT = WS_WB + 2 * MiB, WS_WQ = WS_WOUT + 2 * MiB;
constexpr size_t WS_WKV = WS_WQ + 2 * MiB, WS_WO = WS_WKV + 4 * MiB, WS_WI = WS_WO + 2 * MiB, WS_WO2 = WS_WI + 11 * MiB;
constexpr size_t WS_TAB = WS_WO2 + 6 * MiB;
static_assert(WS_TAB + 65536 <= 48 * MiB, "weights region");
constexpr size_t WS_R = 48 * MiB;
constexpr size_t WS_GATES = WS_R;
constexpr size_t WS_PROJ = WS_R + 192 * MiB;
constexpr size_t WS_GVT = WS_PROJ + 120 * MiB;
constexpr size_t WS_XN = WS_GVT + 32 * MiB;
constexpr size_t WS_OFB = WS_XN + 32 * MiB;
constexpr size_t WS_KMEM = WS_OFB + 64 * MiB;
constexpr size_t WS_VTMEM = WS_KMEM + 12 * MiB;
constexpr size_t WS_END = WS_VTMEM + 12 * MiB;
static_assert(WS_END == 512 * MiB, "ws map");
constexpr size_t WS_Y = WS_R + 192 * MiB;
constexpr size_t WS_H = WS_R + 288 * MiB;
constexpr size_t WS_QX = WS_R;
constexpr size_t WS_OX = WS_R + 96 * MiB;
constexpr size_t WS_ACT = WS_R;
static_assert(WS_ACT + (size_t)MTOT * DFF * 2 <= WS_H, "act overlay");
static_assert(WS_H + 96 * MiB <= WS_KMEM, "H overlay");
constexpr int LDS_BYTES = 147456;
constexpr int LDS_MISC = 147456 - 256;

namespace pg8 {
#define PG8_LAS __attribute__((address_space(3)))
constexpr int BM = 256, BK = 64, HALF = 128, HTB = HALF * BK * 2, STAGE_BYTES = 8 * HTB, NXCD = 8, WGM = 8;
__host__ __device__ __forceinline__ int lds_byte(int r, int c) { const int st = (r >> 4) * 2 + (c >> 5), rr = r & 15, cc = c & 31, ob = rr * 64 + cc * 2; return st * 1024 + (ob ^ (((ob >> 9) & 1) << 5)); }
__host__ __device__ __forceinline__ void stage_rc(int b, int& R, int& C) { const int st = b / 1024, sb = b % 1024, swz = sb ^ (((sb >> 9) & 1) << 5); R = (st >> 1) * 16 + swz / 64; C = (st & 1) * 32 + (swz % 64) / 2; }
__host__ __device__ __forceinline__ int perm32(int rho) { const int n = rho >> 4, i = rho & 15; return 8 * (i >> 2) + 4 * n + (i & 3); }
struct Unit { int pm, pn; };
struct Gemm { const bf16_t* A; const bf16_t* Bt; int M, N, K, lda, ldb; };
struct StaticOrder {
    int nM, nN, nwg, G, c, rep = 1;
    __host__ __device__ void init(int M, int N, int G_, int c_) { nM = M / BM; nN = N / BM; nwg = nM * nN; G = G_; c = c_; }
    __host__ __device__ bool next(int i, Unit& u) const {
        const long L = (long)i * G + c; if (L >= (long)nwg * rep) return false;
        int wgid = (int)(L % nwg); { const int q = nwg / NXCD, r = nwg % NXCD, xcd = wgid % NXCD, off = wgid / NXCD; wgid = (xcd < r ? xcd * (q + 1) : r * (q + 1) + (xcd - r) * q) + off; }
        const int nig = WGM * nN, gid = wgid / nig, fm = gid * WGM, gsz = (nM - fm) < WGM ? (nM - fm) : WGM;
        u.pm = fm + ((wgid % nig) % gsz); u.pn = (wgid % nig) / gsz; return true;
    }
    __device__ __forceinline__ void a_ready(const Unit&) const {}
    __device__ __forceinline__ void done(const Unit&) const {}
};
template <class Epi, class Sched, bool ALIGN_EPI = false, bool SP2 = false>
__device__ __forceinline__ void gemm_phase(PG8_LAS unsigned char* lds, const Gemm g, const Sched& S, const Epi& E) {
    const int tid = threadIdx.x, wid = __builtin_amdgcn_readfirstlane(tid >> 6), lane = tid & 63, wr = wid >> 2, wc = wid & 3, fr = lane & 15, fq = lane >> 4;
    const int K = g.K, nt = K / BK;
    unsigned voffA[2], voffB[2];
#pragma unroll
    for (int i = 0; i < 2; ++i) { int R, C; stage_rc(tid * 16 + i * 8192, R, C); const int Rb = Epi::PERM ? ((R & ~31) + perm32(R & 31)) : R;
        voffA[i] = (unsigned)(R * g.lda + C) * 2u; voffB[i] = (unsigned)(Rb * g.ldb + C) * 2u; }
    const size_t kstep = (size_t)(BK * 2);
    const size_t hstepA = (size_t)HALF * g.lda * 2, hstepB = (size_t)HALF * g.ldb * 2;
    const size_t tstepA = 2 * hstepA, tstepB = 2 * hstepB;
    const unsigned ldsw = (unsigned)wid * 1024u;
    const int aoff = lds_byte(wr * 64 + fr, fq * 8), boff = lds_byte(wc * 32 + fr, fq * 8);
#define PG8_SA(b, h) (((b) * 2 + (h)) * HTB)
#define PG8_SB(b, h) ((4 + (b) * 2 + (h)) * HTB)
#define PG8_STAGE(bufoff, gbase, voff) do { _Pragma("unroll") for (int _i = 0; _i < 2; ++_i) \
        __builtin_amdgcn_global_load_lds((const unsigned*)((const char*)(gbase) + (voff)[_i]), (PG8_LAS unsigned*)(lds + (bufoff) + ldsw + _i * 8192), 16, 0, 0); } while (0)
#define PG8_LDA(dst, b, h) do { _Pragma("unroll") for (int m = 0; m < 4; ++m) _Pragma("unroll") for (int k = 0; k < 2; ++k) dst[m][k] = *(const PG8_LAS bf16x8*)(lds + PG8_SA(b, h) + aoff + m * 2048 + k * 1024); } while (0)
#define PG8_LDB(dst, b, h) do { _Pragma("unroll") for (int n = 0; n < 2; ++n) _Pragma("unroll") for (int k = 0; k < 2; ++k) dst[n][k] = *(const PG8_LAS bf16x8*)(lds + PG8_SB(b, h) + boff + n * 2048 + k * 1024); } while (0)
#define PG8_MMA(ai, bj, At, Bt) do { __builtin_amdgcn_s_setprio(1); _Pragma("unroll") for (int m = 0; m < 4; ++m) _Pragma("unroll") for (int n = 0; n < 2; ++n) _Pragma("unroll") for (int k = 0; k < 2; ++k) \
        acc[ai][bj][m][n] = __builtin_amdgcn_mfma_f32_16x16x32_bf16(Bt[n][k], At[m][k], acc[ai][bj][m][n], 0, 0, 0); __builtin_amdgcn_s_setprio(0); } while (0)
#define PG8_WAIT_V(n) asm volatile("s_waitcnt vmcnt(" #n ")" ::: "memory")
#define PG8_WAIT_L(n) asm volatile("s_waitcnt lgkmcnt(" #n ")" ::: "memory")
#define PG8_BAR __builtin_amdgcn_s_barrier()
#define PG8_SCHED __builtin_amdgcn_sched_barrier(0)
    Unit cur, nxt, prv; int ui = 0; bool has_prv = false;
    if (!S.next(0, cur)) return;
    f32x4 acc[2][2][4][2];
#pragma unroll
    for (int a = 0; a < 2; ++a)
#pragma unroll
        for (int b = 0; b < 2; ++b)
#pragma unroll
            for (int m = 0; m < 4; ++m)
#pragma unroll
                for (int n = 0; n < 2; ++n) acc[a][b][m][n] = (f32x4){0.f, 0.f, 0.f, 0.f};
    bf16x8 At[4][2], B0[2][2], B1[2][2];
    const char* cA = (const char*)g.A + (size_t)cur.pm * tstepA; const char* cB = (const char*)g.Bt + (size_t)cur.pn * tstepB;
    S.a_ready(cur);
    if constexpr (SP2) {
        PG8_STAGE(PG8_SB(0, 0), cB, voffB); PG8_STAGE(PG8_SB(0, 1), cB + hstepB, voffB); PG8_STAGE(PG8_SA(0, 0), cA, voffA); PG8_STAGE(PG8_SA(0, 1), cA + hstepA, voffA);
        if (wr == 1) PG8_BAR;
        PG8_WAIT_V(2); PG8_BAR;
        PG8_STAGE(PG8_SB(1, 0), cB + kstep, voffB); PG8_STAGE(PG8_SA(1, 0), cA + kstep, voffA); PG8_STAGE(PG8_SB(1, 1), cB + hstepB + kstep, voffB);
        PG8_WAIT_V(6); PG8_BAR;
    } else {
        PG8_STAGE(PG8_SB(0, 0), cB, voffB); PG8_STAGE(PG8_SA(0, 0), cA, voffA); PG8_STAGE(PG8_SB(0, 1), cB + hstepB, voffB); PG8_STAGE(PG8_SA(0, 1), cA + hstepA, voffA);
        if (wr == 1) PG8_BAR;
        PG8_WAIT_V(4); PG8_BAR;
        PG8_STAGE(PG8_SB(1, 0), cB + kstep, voffB); PG8_STAGE(PG8_SA(1, 0), cA + kstep, voffA); PG8_STAGE(PG8_SB(1, 1), cB + hstepB + kstep, voffB);
        PG8_WAIT_V(6); PG8_BAR;
    }
    for (;;) {
        const bool has_next = S.next(ui + 1, nxt);
        const char* nA = has_next ? (const char*)g.A + (size_t)nxt.pm * tstepA : cA; const char* nB = has_next ? (const char*)g.Bt + (size_t)nxt.pn * tstepB : cB;
        for (int t = 0; t < nt; t += 2) {
            const bool last = (t == nt - 2);
            const char* a1 = cA + (size_t)(t + 1) * kstep;
            const char* a2 = last ? nA : cA + (size_t)(t + 2) * kstep; const char* b2 = last ? nB : cB + (size_t)(t + 2) * kstep;
            const char* a3 = a2 + kstep; const char* b3 = b2 + kstep;
            if (last && has_next) S.a_ready(nxt);
            if constexpr (SP2) {
            PG8_LDB(B0, 0, 0); PG8_LDB(B1, 0, 1); PG8_SCHED; PG8_LDA(At, 0, 0); PG8_STAGE(PG8_SA(1, 1), a1 + hstepA, voffA);
            PG8_WAIT_V(8); PG8_WAIT_L(0); PG8_BAR; PG8_MMA(0, 0, At, B0); PG8_MMA(0, 1, At, B1); PG8_BAR; PG8_SCHED;
            PG8_LDA(At, 0, 1); PG8_STAGE(PG8_SB(0, 0), b2, voffB); PG8_STAGE(PG8_SB(0, 1), b2 + hstepB, voffB); PG8_STAGE(PG8_SA(0, 0), a2, voffA);
            PG8_WAIT_V(8); PG8_WAIT_L(0); PG8_BAR; PG8_MMA(1, 0, At, B0); PG8_MMA(1, 1, At, B1); PG8_BAR; PG8_SCHED;
            PG8_LDB(B0, 1, 0); PG8_LDB(B1, 1, 1); PG8_SCHED; PG8_LDA(At, 1, 0); PG8_STAGE(PG8_SA(0, 1), a2 + hstepA, voffA);
            PG8_WAIT_V(8); PG8_WAIT_L(0); PG8_BAR; PG8_MMA(0, 0, At, B0); PG8_MMA(0, 1, At, B1); PG8_BAR; PG8_SCHED;
            PG8_LDA(At, 1, 1); PG8_STAGE(PG8_SB(1, 0), b3, voffB); PG8_STAGE(PG8_SB(1, 1), b3 + hstepB, voffB); PG8_STAGE(PG8_SA(1, 0), a3, voffA);
            PG8_WAIT_V(8); PG8_WAIT_L(0); PG8_BAR; PG8_MMA(1, 0, At, B0); PG8_MMA(1, 1, At, B1); PG8_BAR; PG8_SCHED;
            } else {
            PG8_LDB(B0, 0, 0); PG8_SCHED; PG8_LDA(At, 0, 0); PG8_STAGE(PG8_SA(1, 1), a1 + hstepA, voffA);
            PG8_WAIT_L(8); PG8_BAR; PG8_WAIT_L(0); PG8_MMA(0, 0, At, B0); PG8_BAR; PG8_SCHED;
            PG8_LDB(B1, 0, 1); PG8_STAGE(PG8_SB(0, 0), b2, voffB);
            PG8_BAR; PG8_WAIT_L(0); PG8_MMA(0, 1, At, B1); PG8_BAR;
            PG8_LDA(At, 0, 1); PG8_STAGE(PG8_SA(0, 0), a2, voffA);
            PG8_BAR; PG8_WAIT_L(0); PG8_MMA(1, 0, At, B0); PG8_BAR; PG8_SCHED;
            PG8_STAGE(PG8_SB(0, 1), b2 + hstepB, voffB);
            PG8_WAIT_V(6); PG8_BAR; PG8_MMA(1, 1, At, B1); PG8_BAR;
            PG8_LDB(B0, 1, 0); PG8_SCHED; PG8_LDA(At, 1, 0); PG8_STAGE(PG8_SA(0, 1), a2 + hstepA, voffA);
            PG8_WAIT_L(8); PG8_BAR; PG8_WAIT_L(0); PG8_MMA(0, 0, At, B0); PG8_BAR; PG8_SCHED;
            PG8_LDB(B1, 1, 1); PG8_STAGE(PG8_SB(1, 0), b3, voffB);
            PG8_BAR; PG8_WAIT_L(0); PG8_MMA(0, 1, At, B1); PG8_BAR;
            PG8_LDA(At, 1, 1); PG8_STAGE(PG8_SA(1, 0), a3, voffA);
            PG8_BAR; PG8_WAIT_L(0); PG8_MMA(1, 0, At, B0); PG8_BAR; PG8_SCHED;
            PG8_STAGE(PG8_SB(1, 1), b3 + hstepB, voffB);
            PG8_WAIT_V(6); PG8_BAR; PG8_MMA(1, 1, At, B1); PG8_BAR;
            }
        }
        if constexpr (ALIGN_EPI) { if (wr == 0) PG8_BAR; }
        if constexpr (!Epi::AFTER_DRAIN) { E(acc, cur, wr, wc, fr, fq); S.done(cur); }
        if constexpr (Epi::DEFER) { if (has_prv) E.deferred(prv); prv = cur; has_prv = true; }
        if (!has_next) break;
#pragma unroll
        for (int a = 0; a < 2; ++a)
#pragma unroll
            for (int b = 0; b < 2; ++b)
#pragma unroll
                for (int m = 0; m < 4; ++m)
#pragma unroll
                    for (int n = 0; n < 2; ++n) acc[a][b][m][n] = (f32x4){0.f, 0.f, 0.f, 0.f};
        cur = nxt; cA = nA; cB = nB; ++ui;
        if constexpr (ALIGN_EPI) { if (wr == 1) PG8_BAR; }
    }
    PG8_WAIT_V(0);
    if constexpr (!ALIGN_EPI) { if (wr == 0) PG8_BAR; }
    PG8_BAR;
    if constexpr (Epi::AFTER_DRAIN) { E.fused(acc, cur, wr, wc, fr, fq, lds, wid, lane); S.done(cur); }
    if constexpr (Epi::DEFER) { if (has_prv) E.deferred(prv); }
#undef PG8_SA
#undef PG8_SB
#undef PG8_STAGE
#undef PG8_LDA
#undef PG8_LDB
#undef PG8_MMA
#undef PG8_WAIT_V
#undef PG8_WAIT_L
#undef PG8_BAR
#undef PG8_SCHED
}
}

struct EpiStore {
    static constexpr bool PERM = true, AFTER_DRAIN = false, DEFER = false;
    bf16_t* O; int ldc;
    DI void operator()(const f32x4 (&acc)[2][2][4][2], const pg8::Unit& u, int wr, int wc, int fr, int fq) const {
        const int row0 = u.pm * 256 + wr * 64 + fr, col0 = u.pn * 256 + wc * 32 + 8 * fq;
#pragma unroll
        for (int ai = 0; ai < 2; ++ai)
#pragma unroll
            for (int m = 0; m < 4; ++m) { bf16_t* rowp = O + (size_t)(row0 + ai * 128 + m * 16) * ldc + col0;
#pragma unroll
                for (int bj = 0; bj < 2; ++bj) { const f32x4 v0 = acc[ai][bj][m][0], v1 = acc[ai][bj][m][1];
                    u32x4 w; w.x = pk2(v0[0], v0[1]); w.y = pk2(v0[2], v0[3]); w.z = pk2(v1[0], v1[1]); w.w = pk2(v1[2], v1[3]);
                    *(u32x4*)(rowp + bj * 128) = w; } }
    }
};
struct EpiProj {
    static constexpr bool PERM = true, AFTER_DRAIN = false, DEFER = false;
    bf16_t* proj; bf16_t* gates;
    DI void operator()(const f32x4 (&acc)[2][2][4][2], const pg8::Unit& u, int wr, int wc, int fr, int fq) const {
        const bool isg = u.pn >= NPROJ_TILES;
        bf16_t* base = isg ? gates : proj; const int ldc = isg ? 2048 : LDP; const int colt = isg ? (u.pn - NPROJ_TILES) * 256 : u.pn * 256;
        const int row0 = u.pm * 256 + wr * 64 + fr, col0 = colt + wc * 32 + 8 * fq;
#pragma unroll
        for (int ai = 0; ai < 2; ++ai)
#pragma unroll
            for (int m = 0; m < 4; ++m) { bf16_t* rowp = base + (size_t)(row0 + ai * 128 + m * 16) * ldc + col0;
#pragma unroll
                for (int bj = 0; bj < 2; ++bj) { f32x4 v0 = acc[ai][bj][m][0], v1 = acc[ai][bj][m][1];
                    if (isg) {
#pragma unroll
                        for (int j = 0; j < 4; ++j) { v0[j] = sigmoidf_(v0[j]); v1[j] = sigmoidf_(v1[j]); } }
                    u32x4 w; w.x = pk2(v0[0], v0[1]); w.y = pk2(v0[2], v0[3]); w.z = pk2(v1[0], v1[1]); w.w = pk2(v1[2], v1[3]);
                    *(u32x4*)(rowp + bj * 128) = w; } }
    }
};
struct EpiGate {
    static constexpr bool PERM = true, AFTER_DRAIN = false, DEFER = false;
    bf16_t* G; int second;
    DI void operator()(const f32x4 (&acc)[2][2][4][2], const pg8::Unit& u, int wr, int wc, int fr, int fq) const {
        const int row0 = u.pm * 256 + wr * 64 + fr, col0 = u.pn * 256 + wc * 32 + 8 * fq;
#pragma unroll
        for (int ai = 0; ai < 2; ++ai) {
            u32x4 gv[4][2], pv[4][2];
#pragma unroll
            for (int m = 0; m < 4; ++m) { const bf16_t* rowp = G + (size_t)(row0 + ai * 128 + m * 16) * 2048 + col0;
#pragma unroll
                for (int bj = 0; bj < 2; ++bj) { gv[m][bj] = *(const u32x4*)(rowp + bj * 128 + (second ? 1024 : 0)); if (second) pv[m][bj] = *(const u32x4*)(rowp + bj * 128); } }
            asm volatile("" ::: "memory");
#pragma unroll
            for (int m = 0; m < 4; ++m) { bf16_t* rowp = G + (size_t)(row0 + ai * 128 + m * 16) * 2048 + col0;
#pragma unroll
                for (int bj = 0; bj < 2; ++bj) { const f32x4 v0 = acc[ai][bj][m][0], v1 = acc[ai][bj][m][1];
                    const u32x4 g = gv[m][bj];
                    float r[8];
                    r[0] = bf_lo(g.x) * v0[0]; r[1] = bf_hi(g.x) * v0[1]; r[2] = bf_lo(g.y) * v0[2]; r[3] = bf_hi(g.y) * v0[3];
                    r[4] = bf_lo(g.z) * v1[0]; r[5] = bf_hi(g.z) * v1[1]; r[6] = bf_lo(g.w) * v1[2]; r[7] = bf_hi(g.w) * v1[3];
                    if (second) { const u32x4 p = pv[m][bj];
                        r[0] += bf_lo(p.x); r[1] += bf_hi(p.x); r[2] += bf_lo(p.y); r[3] += bf_hi(p.y); r[4] += bf_lo(p.z); r[5] += bf_hi(p.z); r[6] += bf_lo(p.w); r[7] += bf_hi(p.w); }
                    u32x4 w; w.x = pk2(r[0], r[1]); w.y = pk2(r[2], r[3]); w.z = pk2(r[4], r[5]); w.w = pk2(r[6], r[7]);
                    *(u32x4*)(rowp + bj * 128) = w; } }
            asm volatile("" ::: "memory");
        }
    }
};
struct EpiSwiglu {
    static constexpr bool PERM = true, AFTER_DRAIN = false, DEFER = false;
    bf16_t* O;
    DI void operator()(const f32x4 (&acc)[2][2][4][2], const pg8::Unit& u, int wr, int wc, int fr, int fq) const {
        const int row0 = u.pm * 256 + wr * 64 + fr, col0 = u.pn * 128 + wc * 32 + 8 * fq;
#pragma unroll
        for (int ai = 0; ai < 2; ++ai)
#pragma unroll
            for (int m = 0; m < 4; ++m) { bf16_t* rowp = O + (size_t)(row0 + ai * 128 + m * 16) * DFF + col0;
                float r[8];
#pragma unroll
                for (int n = 0; n < 2; ++n)
#pragma unroll
                    for (int j = 0; j < 4; ++j) { const float g = acc[ai][0][m][n][j], uu = acc[ai][1][m][n][j]; r[4 * n + j] = g * sigmoidf_(g) * uu; }
                u32x4 w; w.x = pk2(r[0], r[1]); w.y = pk2(r[2], r[3]); w.z = pk2(r[4], r[5]); w.w = pk2(r[6], r[7]);
                *(u32x4*)rowp = w; }
    }
};

namespace att {
using s16x4 = __attribute__((ext_vector_type(4))) short;
constexpr int D = 128, NW = 8, QBLK = 32, KVBLK = 64;
constexpr float SCALE = 0.088388347648318440f;
constexpr float THR = 8.f;
constexpr int SHM_V = KVBLK * D * 2, SHM_K = KVBLK * D * 2, SHM_ATTN = 2 * SHM_V + 2 * SHM_K + NW * 64 * 4;
#define KSWZ(row, colB) ((row) * 256 + ((colB) ^ (((row) & 7) << 4)))
#define SBAR() __builtin_amdgcn_sched_barrier(0)
DI unsigned cvtpk(float lo, float hi) { unsigned r; asm volatile("v_cvt_pk_bf16_f32 %0, %1, %2" : "=v"(r) : "v"(lo), "v"(hi)); return r; }
DI void partialSM(f32x16& p0, f32x16& p1, float& m_reg, float& mn, float& alpha) {
  constexpr float C = SCALE * 1.4426950408889634f;
  float pmax = p0[0]; for (int r = 1; r < 16; ++r) pmax = fmaxf(pmax, p0[r]); for (int r = 0; r < 16; ++r) pmax = fmaxf(pmax, p1[r]);
  { auto rr = __builtin_amdgcn_permlane32_swap(__float_as_uint(pmax), __float_as_uint(pmax), false, false);
    pmax = fmaxf(__uint_as_float(rr[0]), __uint_as_float(rr[1])); }
  if (__builtin_expect(__all(pmax - m_reg <= THR / SCALE), 1)) { mn = m_reg; alpha = 1.f; }
  else { mn = fmaxf(m_reg, pmax); alpha = __builtin_amdgcn_exp2f((m_reg - mn) * C); m_reg = mn; }
  float mnC = -mn * C;
  for (int r = 0; r < 16; ++r) p0[r] = fmaf(p0[r], C, mnC); for (int r = 0; r < 16; ++r) p1[r] = fmaf(p1[r], C, mnC);
  for (int r = 0; r < 16; ++r) p0[r] = __builtin_amdgcn_exp2f(p0[r]);
}
DI void finishSM(f32x16& p0, f32x16& p1, float alpha, float& l_reg, bf16x8& pa0, bf16x8& pa1, bf16x8& pa2, bf16x8& pa3) {
  for (int r = 0; r < 16; ++r) p1[r] = __builtin_amdgcn_exp2f(p1[r]);
  float ps = 0; for (int r = 0; r < 16; ++r) ps += p0[r]; for (int r = 0; r < 16; ++r) ps += p1[r];
  { auto rr = __builtin_amdgcn_permlane32_swap(__float_as_uint(ps), __float_as_uint(ps), false, false);
    ps = __uint_as_float(rr[0]) + __uint_as_float(rr[1]); }
  l_reg = l_reg * alpha + ps;
#define PK4(P, BASE, OUT) do { unsigned a0 = cvtpk(P[BASE + 0], P[BASE + 1]), a1 = cvtpk(P[BASE + 2], P[BASE + 3]);   \
    unsigned b0 = cvtpk(P[BASE + 4], P[BASE + 5]), b1 = cvtpk(P[BASE + 6], P[BASE + 7]);                              \
    auto r0 = __builtin_amdgcn_permlane32_swap(a0, b0, false, false); auto r1 = __builtin_amdgcn_permlane32_swap(a1, b1, false, false); \
    u32x4 w = {r0[0], r1[0], r0[1], r1[1]}; OUT = *reinterpret_cast<bf16x8*>(&w); } while (0)
  PK4(p0, 0, pa0); PK4(p0, 8, pa1); PK4(p1, 0, pa2); PK4(p1, 8, pa3);
#undef PK4
}
DI void qkt(f32x16& p0, f32x16& p1, const LAS char* Ks, const bf16x8* qr, int r32, int hi) {
  p0 = f32x16{}; p1 = f32x16{};
  for (int d0 = 0; d0 < 8; ++d0) { int cb = (d0 * 16 + hi * 8) * 2;
    bf16x8 b0 = *reinterpret_cast<const LAS bf16x8*>(Ks + KSWZ(r32, cb));
    bf16x8 b1 = *reinterpret_cast<const LAS bf16x8*>(Ks + KSWZ(32 + r32, cb));
    p0 = MFMA32(b0, qr[d0], p0);
    p1 = MFMA32(b1, qr[d0], p1); }
}
DI int v_st(int k, int c) { const int kk = (k & ~0xC) | ((k & 4) << 1) | ((k & 8) >> 1); return ((kk >> 3) * 4 + (c >> 5)) * 512 + ((kk & 7) * 32 + (c & 31)) * 2; }
DI int v_rd_base(int lane) { return ((lane & 3) << 3) | (((lane >> 2) & 3) << 6) | (((lane >> 4) & 1) << 5) | (((lane >> 5) & 1) << 8); }
constexpr int v_rd_off(int d0, int ks, int half) { return d0 * 512 + ks * 4096 + half * 2048; }
template <int OFF> DI s16x4 tr_read(int vb) {
  s16x4 r; asm volatile("ds_read_b64_tr_b16 %0, %1 offset:%2" : "=&v"(r) : "v"(vb), "i"(OFF) : "memory"); return r;
}
template <int D0> DI void pv_one(f32x16& od, int vb, bf16x8 pa0, bf16x8 pa1, bf16x8 pa2, bf16x8 pa3) {
  const s16x4 l0 = tr_read<v_rd_off(D0, 0, 0)>(vb), h0 = tr_read<v_rd_off(D0, 0, 1)>(vb), l1 = tr_read<v_rd_off(D0, 1, 0)>(vb), h1 = tr_read<v_rd_off(D0, 1, 1)>(vb);
  const s16x4 l2 = tr_read<v_rd_off(D0, 2, 0)>(vb), h2 = tr_read<v_rd_off(D0, 2, 1)>(vb), l3 = tr_read<v_rd_off(D0, 3, 0)>(vb), h3 = tr_read<v_rd_off(D0, 3, 1)>(vb);
  asm volatile("s_waitcnt lgkmcnt(0)" ::: "memory"); SBAR();
#define PK(L, H) (bf16x8){L[0], L[1], L[2], L[3], H[0], H[1], H[2], H[3]}
  od = MFMA32(pa0, PK(l0, h0), od);
  od = MFMA32(pa1, PK(l1, h1), od);
  od = MFMA32(pa2, PK(l2, h2), od);
  od = MFMA32(pa3, PK(l3, h3), od);
#undef PK
}
DI void pv_d0(f32x16* o, int vb, bf16x8 pa0, bf16x8 pa1, bf16x8 pa2, bf16x8 pa3) {
  pv_one<0>(o[0], vb, pa0, pa1, pa2, pa3); pv_one<1>(o[1], vb, pa0, pa1, pa2, pa3); pv_one<2>(o[2], vb, pa0, pa1, pa2, pa3); pv_one<3>(o[3], vb, pa0, pa1, pa2, pa3);
}
template <int LDQ, int LDK, int LDO>
DI void attn_dense_body(const bf16_t* __restrict__ Qb, const bf16_t* __restrict__ Kh, const bf16_t* __restrict__ Vh, bf16_t* __restrict__ Ob, int seq, LAS char* lds,
                        const float* __restrict__ qn, const float* __restrict__ tab, int tq0) {
  const int tid = tid_opaque(), wid = tid >> 6, lane = tid & 63, r32 = lane & 31, hi = lane >> 5;
  LAS char* V_lds = lds; LAS char* K_lds = lds + 2 * SHM_V;
  LAS float* ws = (LAS float*)(lds + 2 * SHM_V + 2 * SHM_K) + wid * 64; LAS float* li_l = ws; LAS float* al_l = ws + 32;
  float m_reg = -1e30f, l_reg = 0; f32x16 o[4] = {}; bf16x8 qr[8];
  const bf16_t* Qw = Qb + (long)(wid * QBLK + r32) * LDQ + hi * 8;
  {
    u32x4 raw[8];
#pragma unroll
    for (int d0 = 0; d0 < 8; ++d0) raw[d0] = *reinterpret_cast<const u32x4*>(Qw + d0 * 16);
    float ss = 0.f;
#pragma unroll
    for (int d0 = 0; d0 < 8; ++d0) { const float a0 = bf_lo(raw[d0].x), a1 = bf_hi(raw[d0].x), a2 = bf_lo(raw[d0].y), a3 = bf_hi(raw[d0].y), a4 = bf_lo(raw[d0].z), a5 = bf_hi(raw[d0].z), a6 = bf_lo(raw[d0].w), a7 = bf_hi(raw[d0].w);
      ss += ((a0 * a0 + a1 * a1) + (a2 * a2 + a3 * a3)) + ((a4 * a4 + a5 * a5) + (a6 * a6 + a7 * a7)); }
    ss += __shfl_xor(ss, 32);
    const float rstd = rsqrtf(ss * (1.f / 128.f) + 1e-6f);
    const int tq = tq0 + wid * QBLK + r32;
#pragma unroll
    for (int blk = 0; blk < 2; ++blk) {
      const int pos = blk ? (tq & 63) : (tq >> 6);
#pragma unroll
      for (int dd = 0; dd < 2; ++dd) {
        const int d0 = 4 * blk + dd, fb = dd * 16 + hi * 8;
        float x1[8], x2[8];
        x1[0] = bf_lo(raw[d0].x); x1[1] = bf_hi(raw[d0].x); x1[2] = bf_lo(raw[d0].y); x1[3] = bf_hi(raw[d0].y); x1[4] = bf_lo(raw[d0].z); x1[5] = bf_hi(raw[d0].z); x1[6] = bf_lo(raw[d0].w); x1[7] = bf_hi(raw[d0].w);
        x2[0] = bf_lo(raw[d0 + 2].x); x2[1] = bf_hi(raw[d0 + 2].x); x2[2] = bf_lo(raw[d0 + 2].y); x2[3] = bf_hi(raw[d0 + 2].y); x2[4] = bf_lo(raw[d0 + 2].z); x2[5] = bf_hi(raw[d0 + 2].z); x2[6] = bf_lo(raw[d0 + 2].w); x2[7] = bf_hi(raw[d0 + 2].w);
        float o1[8], o2[8];
#pragma unroll
        for (int hx = 0; hx < 2; ++hx) {
          const f32x4 g1 = *(const f32x4*)(qn + d0 * 16 + hi * 8 + 4 * hx), g2 = *(const f32x4*)(qn + (d0 + 2) * 16 + hi * 8 + 4 * hx);
          const f32x4 cs = *(const f32x4*)(tab + pos * 32 + fb + 4 * hx), sn = *(const f32x4*)(tab + 2048 + pos * 32 + fb + 4 * hx);
#pragma unroll
          for (int x = 0; x < 4; ++x) { const float a = x1[4 * hx + x] * rstd * g1[x], b = x2[4 * hx + x] * rstd * g2[x];
            o1[4 * hx + x] = a * cs[x] - b * sn[x]; o2[4 * hx + x] = b * cs[x] + a * sn[x]; }
        }
        u32x4 w1, w2;
        w1.x = pk2(o1[0], o1[1]); w1.y = pk2(o1[2], o1[3]); w1.z = pk2(o1[4], o1[5]); w1.w = pk2(o1[6], o1[7]);
        w2.x = pk2(o2[0], o2[1]); w2.y = pk2(o2[2], o2[3]); w2.z = pk2(o2[4], o2[5]); w2.w = pk2(o2[6], o2[7]);
        qr[d0] = __builtin_bit_cast(bf16x8, w1); qr[d0 + 2] = __builtin_bit_cast(bf16x8, w2);
      }
    }
  }
  const int sr = tid >> 4, sc = (tid & 15) * 8, vst0 = v_st(sr, sc), vst1 = v_st(32 + sr, sc);
  const int vb0 = (int)(uintptr_t)V_lds + v_rd_base(lane);
  struct { bf16x8 vs0, vs1, ks0, ks1; } sr_[2];
#define SLOAD(i, k0) do { sr_[i].vs0 = *reinterpret_cast<const bf16x8*>(&Vh[(long)((k0) + sr) * LDK + sc]); sr_[i].vs1 = *reinterpret_cast<const bf16x8*>(&Vh[(long)((k0) + 32 + sr) * LDK + sc]); \
    sr_[i].ks0 = *reinterpret_cast<const bf16x8*>(&Kh[(long)((k0) + sr) * LDK + sc]); sr_[i].ks1 = *reinterpret_cast<const bf16x8*>(&Kh[(long)((k0) + 32 + sr) * LDK + sc]); } while (0)
#define SWRITE(b, i) do { *(LAS bf16x8*)(V_lds + (b) * SHM_V + vst0) = sr_[i].vs0;          \
    *(LAS bf16x8*)(V_lds + (b) * SHM_V + vst1) = sr_[i].vs1; int kc = sc * 2;               \
    *(LAS bf16x8*)(K_lds + (b) * SHM_K + KSWZ(sr, kc)) = sr_[i].ks0;                       \
    *(LAS bf16x8*)(K_lds + (b) * SHM_K + KSWZ(32 + sr, kc)) = sr_[i].ks1; } while (0)
#define SWAIT() asm volatile("s_waitcnt vmcnt(4)" ::: "memory")
#define RESC(a) do { if (__any((a) < 1.f)) { if (hi == 0) al_l[r32] = (a); asm volatile("s_waitcnt lgkmcnt(0)" ::: "memory"); \
    for (int d = 0; d < 4; ++d) for (int r = 0; r < 16; ++r) o[d][r] *= al_l[crow(r, hi)]; } } while (0)
  f32x16 pA0, pA1, pB0, pB1; float mnA, mnB, alA, alB; bf16x8 pa0, pa1, pa2, pa3; const int NT = seq / KVBLK;
  constexpr int SE = 0, SO = 1;
  SLOAD(SE, 0); asm volatile("s_waitcnt vmcnt(0)" ::: "memory"); SWRITE(0, SE); __syncthreads();
  qkt(pA0, pA1, K_lds, qr, r32, hi); partialSM(pA0, pA1, m_reg, mnA, alA);
  SLOAD(SO, KVBLK); if (2 < NT) SLOAD(SE, 2 * KVBLK);
  SWAIT(); SWRITE(1, SO); __syncthreads();
  for (int j = 1; j + 1 < NT; j += 2) {
    SBAR(); qkt(pB0, pB1, K_lds + SHM_K, qr, r32, hi);
    finishSM(pA0, pA1, alA, l_reg, pa0, pa1, pa2, pa3); SBAR();
    SLOAD(SO, (j + 2) * KVBLK); SBAR();
    pv_d0(o, vb0, pa0, pa1, pa2, pa3); partialSM(pB0, pB1, m_reg, mnB, alB);
    __syncthreads(); SWAIT(); SWRITE(0, SE);
    RESC(alB); __syncthreads();
    SBAR(); qkt(pA0, pA1, K_lds, qr, r32, hi);
    finishSM(pB0, pB1, alB, l_reg, pa0, pa1, pa2, pa3); SBAR();
    if (j + 3 < NT) SLOAD(SE, (j + 3) * KVBLK); SBAR();
    pv_d0(o, vb0 + (int)SHM_V, pa0, pa1, pa2, pa3); partialSM(pA0, pA1, m_reg, mnA, alA);
    __syncthreads(); SWAIT(); SWRITE(1, SO);
    RESC(alA); __syncthreads();
  }
  SBAR(); qkt(pB0, pB1, K_lds + SHM_K, qr, r32, hi);
  finishSM(pA0, pA1, alA, l_reg, pa0, pa1, pa2, pa3); SBAR();
  pv_d0(o, vb0, pa0, pa1, pa2, pa3); partialSM(pB0, pB1, m_reg, mnB, alB);
  __syncthreads(); RESC(alB);
  finishSM(pB0, pB1, alB, l_reg, pa0, pa1, pa2, pa3); SBAR();
  pv_d0(o, vb0 + (int)SHM_V, pa0, pa1, pa2, pa3);
  if (hi == 0) li_l[r32] = l_reg; asm volatile("s_waitcnt lgkmcnt(0)" ::: "memory");
  float rli[16];
#pragma unroll
  for (int r = 0; r < 16; ++r) rli[r] = __builtin_amdgcn_rcpf(li_l[crow(r, hi)]);
  bf16_t* Ow = Ob + (long)(wid * QBLK) * LDO;
#pragma unroll
  for (int r = 0; r < 16; ++r) { int orow = crow(r, hi);
#pragma unroll
    for (int d0 = 0; d0 < 4; ++d0) Ow[(long)orow * LDO + d0 * 32 + r32] = f2bf(o[d0][r] * rli[r]); }
  __syncthreads();
#undef SLOAD
#undef SWRITE
#undef SWAIT
#undef RESC
}
}

namespace gla {
constexpr int QG_OFF = 0, KG_OFF = 17408, KGT_OFF = 34816, VT_OFF = 53248, PM_OFF = 90112, DEC_OFF = 99328, ZB_OFF = 99840, GB_OFF = 101888;
constexpr float QSCALE = 0.08838834764831845f;
DI void item(LAS char* lds, const bf16_t* __restrict__ proj, const bf16_t* __restrict__ gvt, bf16_t* __restrict__ ofb,
             const float* __restrict__ wa, const float* __restrict__ ba, int bl, int h, int dir) {
    const int tid = tid_opaque(), wid = tid >> 6, lane = tid & 63, r32 = lane & 31, hi = lane >> 5;
    const int d = tid & 127, part = tid >> 7;
    LAS char* QG = lds + QG_OFF; LAS char* KG = lds + KG_OFF; LAS char* KGT = lds + KGT_OFF; LAS char* VT = lds + VT_OFF; LAS char* PM = lds + PM_OFF;
    LAS float* DEC = (LAS float*)(lds + DEC_OFF); LAS char* ZB = lds + ZB_OFF; LAS char* GB = lds + GB_OFF;
    const int xib = wid & 1, xdb = wid >> 1;
    bf16x8 wfrag; float bav;
    { const float* wp = wa + (size_t)(8 * hi) * 512 + h * 128 + 32 * xdb + r32;
      u32x4 w; w.x = pk2(wp[0], wp[512]); w.y = pk2(wp[1024], wp[1536]); w.z = pk2(wp[2048], wp[2560]); w.w = pk2(wp[3072], wp[3584]);
      wfrag = __builtin_bit_cast(bf16x8, w); bav = ba[h * 128 + 32 * xdb + r32]; }
    f32x16 S[4];
#pragma unroll
    for (int i = 0; i < 4; ++i) S[i] = f32x16{};
    const int tb = bl * T;
    const int ew = 32 * wid;
    const int qrow = tid >> 4, qseg = tid & 15;
    const int zrow = (tid & 127) >> 1, zseg = tid & 1;
    const int ve = tid >> 3, vseg = tid & 7;
    u32x4 pq[2], pkk[2], pz, pv[4];
#define GLA_LOAD(cc) do { const int t0_ = tb + (cc) * 64; const bf16_t* cb_ = proj + (size_t)t0_ * LDP; \
        _Pragma("unroll") for (int x = 0; x < 2; ++x) { pq[x] = *(const u32x4*)(cb_ + (size_t)(qrow + 32 * x) * LDP + PC_GQ + h * 128 + qseg * 8); \
            pkk[x] = *(const u32x4*)(cb_ + (size_t)(qrow + 32 * x) * LDP + PC_GK + h * 128 + qseg * 8); } \
        pz = *(const u32x4*)(cb_ + (size_t)zrow * LDP + PC_Z + dir * 16 + zseg * 8); \
        _Pragma("unroll") for (int x = 0; x < 4; ++x) pv[x] = *(const u32x4*)(gvt + (size_t)(h * 256 + ve + 64 * x) * MR + t0_ + vseg * 8); } while (0)
    GLA_LOAD(dir ? 31 : 0);
    for (int n = 0; n < 32; ++n) {
        const int c = dir ? 31 - n : n; const int t0 = tb + c * 64;
        __syncthreads();
#pragma unroll
        for (int x = 0; x < 2; ++x) { *(LAS u32x4*)(QG + (qrow + 32 * x) * 272 + qseg * 16) = pq[x]; *(LAS u32x4*)(KG + (qrow + 32 * x) * 272 + qseg * 16) = pkk[x]; }
        if (tid < 128) *(LAS u32x4*)(ZB + zrow * 32 + zseg * 16) = pz;
#pragma unroll
        for (int x = 0; x < 4; ++x) *(LAS u32x4*)(VT + (ve + 64 * x) * 144 + vseg * 16) = pv[x];
        if (n + 1 < 32) GLA_LOAD(dir ? 30 - n : n + 1);
        __syncthreads();
        {
            const bf16x8 za = *(const LAS bf16x8*)(ZB + (32 * xib + r32) * 32 + hi * 16);
            const f32x16 xa = MFMA32(za, wfrag, f32x16{});
#pragma unroll
            for (int g = 0; g < 4; ++g) { f32x4 gv;
#pragma unroll
                for (int x = 0; x < 4; ++x) { const float xv = xa[4 * g + x] + bav; gv[x] = (fminf(xv, 0.f) - __logf(1.f + __expf(-fabsf(xv)))) * (1.f / 16.f); }
                *(LAS f32x4*)(GB + (32 * xdb + r32) * 272 + (32 * xib + 8 * g + 4 * hi) * 4) = gv; }
        }
        __syncthreads();
        int d = tid & 127, part = tid >> 7; asm volatile("" : "+v"(d), "+v"(part));
        float bc[16]; float tot;
        {
            float ps[4];
#pragma unroll
            for (int p = 0; p < 4; ++p) { float a = 0.f;
#pragma unroll
                for (int q = 0; q < 4; ++q) { const f32x4 v = *(const LAS f32x4*)(GB + d * 272 + p * 64 + q * 16); a += (v[0] + v[1]) + (v[2] + v[3]);
                    if (p == part) { bc[4 * q] = v[0]; bc[4 * q + 1] = v[1]; bc[4 * q + 2] = v[2]; bc[4 * q + 3] = v[3]; } }
                ps[p] = a; }
            tot = (ps[0] + ps[1]) + (ps[2] + ps[3]);
            float off;
            if (dir == 0) off = (part > 0 ? ps[0] : 0.f) + (part > 1 ? ps[1] : 0.f) + (part > 2 ? ps[2] : 0.f);
            else off = (part < 3 ? ps[3] : 0.f) + (part < 2 ? ps[2] : 0.f) + (part < 1 ? ps[1] : 0.f);
            if (dir == 0) { bc[0] += off;
#pragma unroll
                for (int rr = 1; rr < 16; ++rr) bc[rr] += bc[rr - 1];
            } else { bc[15] += off;
#pragma unroll
                for (int rr = 14; rr >= 0; --rr) bc[rr] += bc[rr + 1];
            }
        }
        if (part == 0) DEC[d] = __expf(tot);
        unsigned kpk[8];
#pragma unroll
        for (int rr = 0; rr < 16; rr += 2) {
            float kv2[2];
#pragma unroll
            for (int x = 0; x < 2; ++x) {
                const int i = part * 16 + rr + x;
                LAS bf16_t* qp = (LAS bf16_t*)(QG + i * 272 + d * 2); LAS bf16_t* kp = (LAS bf16_t*)(KG + i * 272 + d * 2);
                const float eb = __expf(bc[rr + x]);
                const float qv = bf2f(*qp) * QSCALE * eb;
                const float kv = bf2f(*kp) * __builtin_amdgcn_rcpf(eb);
                *qp = f2bf(qv); *kp = f2bf(kv);
                kv2[x] = kv;
            }
            kpk[rr >> 1] = pk2(kv2[0], kv2[1]);
        }
        {
            u32x4 w0, w1;
            w0.x = kpk[0]; w0.y = kpk[1]; w0.z = kpk[2]; w0.w = kpk[3]; w1.x = kpk[4]; w1.y = kpk[5]; w1.z = kpk[6]; w1.w = kpk[7];
            *(LAS u32x4*)(KGT + d * 144 + part * 32) = w0; *(LAS u32x4*)(KGT + d * 144 + part * 32 + 16) = w1;
        }
        __syncthreads();
        if (wid < 4) {
            int r32 = lane & 31, hi = lane >> 5; asm volatile("" : "+v"(r32), "+v"(hi));
            const int jb = wid >> 1, ib = wid & 1;
            f32x16 acc = f32x16{};
#pragma unroll
            for (int s = 0; s < 8; ++s) {
                const bf16x8 a = *(const LAS bf16x8*)(KG + (32 * jb + r32) * 272 + (16 * s + 8 * hi) * 2);
                const bf16x8 b = *(const LAS bf16x8*)(QG + (32 * ib + r32) * 272 + (16 * s + 8 * hi) * 2);
                acc = MFMA32(a, b, acc);
            }
            int i = 32 * ib + r32; asm volatile("" : "+v"(i));
#pragma unroll
            for (int g = 0; g < 4; ++g) { const int jbase = 32 * jb + 8 * g + 4 * hi; float v[4];
#pragma unroll
                for (int x = 0; x < 4; ++x) { const int j = jbase + x; const bool keep = dir ? (j > i) : (j <= i); v[x] = keep ? acc[4 * g + x] : 0.f; }
                u32x2 w; w.x = pk2(v[0], v[1]); w.y = pk2(v[2], v[3]);
                *(LAS u32x2*)(PM + i * 144 + jbase * 2) = w; }
        }
        __syncthreads();
        int r32 = lane & 31, hi = lane >> 5; asm volatile("" : "+v"(r32), "+v"(hi));
        f32x16 o[2]; o[0] = f32x16{}; o[1] = f32x16{};
#pragma unroll
        for (int db = 0; db < 4; ++db)
#pragma unroll
            for (int s = 0; s < 2; ++s) {
                u32x4 bw; bw.x = pk2(S[db][8 * s + 0], S[db][8 * s + 1]); bw.y = pk2(S[db][8 * s + 2], S[db][8 * s + 3]);
                bw.z = pk2(S[db][8 * s + 4], S[db][8 * s + 5]); bw.w = pk2(S[db][8 * s + 6], S[db][8 * s + 7]);
                const bf16x8 bfrag = __builtin_bit_cast(bf16x8, bw);
                const int d0 = 32 * db + 16 * s + 4 * hi;
#pragma unroll
                for (int ib = 0; ib < 2; ++ib) {
                    const u32x2 a0 = *(const LAS u32x2*)(QG + (32 * ib + r32) * 272 + d0 * 2), a1 = *(const LAS u32x2*)(QG + (32 * ib + r32) * 272 + (d0 + 8) * 2);
                    u32x4 aw; aw.x = a0.x; aw.y = a0.y; aw.z = a1.x; aw.w = a1.y;
                    o[ib] = MFMA32(__builtin_bit_cast(bf16x8, aw), bfrag, o[ib]);
                }
            }
        bf16x8 vb[4];
#pragma unroll
        for (int s = 0; s < 4; ++s) vb[s] = *(const LAS bf16x8*)(VT + (ew + r32) * 144 + (16 * s + 8 * hi) * 2);
#pragma unroll
        for (int s = 0; s < 4; ++s)
#pragma unroll
            for (int ib = 0; ib < 2; ++ib) { const bf16x8 a = *(const LAS bf16x8*)(PM + (32 * ib + r32) * 144 + (16 * s + 8 * hi) * 2); o[ib] = MFMA32(a, vb[s], o[ib]); }
        {
            LAS char* OS = lds + GB_OFF + wid * 5120;
#pragma unroll
            for (int ib = 0; ib < 2; ++ib)
#pragma unroll
                for (int r = 0; r < 16; ++r) *(LAS bf16_t*)(OS + (32 * ib + crow(r, hi)) * 80 + r32 * 2) = f2bf(o[ib][r]);
            asm volatile("s_waitcnt lgkmcnt(0)" ::: "memory");
#pragma unroll
            for (int x = 0; x < 4; ++x) { const int p = lane + 64 * x, row = p >> 2, seg = p & 3;
                const u32x4 v = *(const LAS u32x4*)(OS + row * 80 + seg * 16);
                *(u32x4*)(ofb + (size_t)(t0 + row) * 1024 + h * 256 + ew + seg * 8) = v; }
        }
#pragma unroll
        for (int db = 0; db < 4; ++db) {
#pragma unroll
            for (int s = 0; s < 4; ++s) { const bf16x8 a = *(const LAS bf16x8*)(KGT + (32 * db + r32) * 144 + (16 * s + 8 * hi) * 2); S[db] = MFMA32(a, vb[s], S[db]); }
#pragma unroll
            for (int g = 0; g < 4; ++g) { const f32x4 dc = *(const LAS f32x4*)(DEC + 32 * db + 8 * g + 4 * hi);
#pragma unroll
                for (int x = 0; x < 4; ++x) S[db][4 * g + x] *= dc[x]; }
        }
    }
    __syncthreads();
#undef GLA_LOAD
}
}

namespace xat {
constexpr int KS_OFF = 0, KS_STRIDE = 528, VS_OFF = 34816, VS_STRIDE = 144, L_OFF = 34816 + 36864;
DI void unit(LAS char* lds, const bf16_t* __restrict__ qx, const bf16_t* __restrict__ kmem, const bf16_t* __restrict__ vtmem, bf16_t* __restrict__ ox, int b, int hx, int qb) {
    const int tid = tid_opaque(), wid = tid >> 6, lane = tid & 63, r32 = lane & 31, hi = lane >> 5;
    LAS char* KS = lds + KS_OFF; LAS char* VS = lds + VS_OFF; LAS float* LL = (LAS float*)(lds + L_OFF) + wid * 32;
    const int m0 = b * T + qb * 256 + wid * 32;
    bf16x8 qf[16];
    { const bf16_t* qp = qx + (size_t)(m0 + r32) * 1024 + hx * 256 + hi * 8;
#pragma unroll
      for (int s = 0; s < 16; ++s) qf[s] = *(const bf16x8*)(qp + 16 * s); }
    f32x16 sc[8];
#pragma unroll
    for (int kt = 0; kt < 4; ++kt) {
#pragma unroll
        for (int x = 0; x < 4; ++x) { const int p = tid + 512 * x, key = p >> 5, seg = p & 31;
            const u32x4 v = *(const u32x4*)(kmem + (size_t)(b * NMEM + 64 * kt + key) * 1024 + hx * 256 + seg * 8);
            *(LAS u32x4*)(KS + key * KS_STRIDE + seg * 16) = v; }
        __syncthreads();
#pragma unroll
        for (int kb = 0; kb < 2; ++kb) { f32x16 acc = f32x16{};
#pragma unroll
            for (int s = 0; s < 16; ++s) { const bf16x8 a = *(const LAS bf16x8*)(KS + (32 * kb + r32) * KS_STRIDE + (16 * s + 8 * hi) * 2); acc = MFMA32(a, qf[s], acc); }
            sc[kt * 2 + kb] = acc; }
        __syncthreads();
    }
    float mx = sc[0][0];
#pragma unroll
    for (int t = 0; t < 8; ++t)
#pragma unroll
        for (int r = 0; r < 16; ++r) mx = fmaxf(mx, sc[t][r]);
    mx = fmaxf(mx, __shfl_xor(mx, 32));
    float sum = 0.f;
    u32x4 pp[8][2];
#pragma unroll
    for (int t = 0; t < 8; ++t) {
#pragma unroll
        for (int r = 0; r < 16; ++r) { const float e = __expf(sc[t][r] - mx); sum += e; sc[t][r] = e; }
#pragma unroll
        for (int s = 0; s < 2; ++s) { pp[t][s].x = pk2(sc[t][8 * s + 0], sc[t][8 * s + 1]); pp[t][s].y = pk2(sc[t][8 * s + 2], sc[t][8 * s + 3]);
            pp[t][s].z = pk2(sc[t][8 * s + 4], sc[t][8 * s + 5]); pp[t][s].w = pk2(sc[t][8 * s + 6], sc[t][8 * s + 7]); }
    }
    sum += __shfl_xor(sum, 32);
    if (hi == 0) LL[r32] = sum;
    f32x16 o[8];
#pragma unroll
    for (int eb = 0; eb < 8; ++eb) o[eb] = f32x16{};
#pragma unroll
    for (int kt = 0; kt < 4; ++kt) {
#pragma unroll
        for (int x = 0; x < 4; ++x) { const int p = tid + 512 * x, e = p >> 3, seg = p & 7;
            const u32x4 v = *(const u32x4*)(vtmem + (size_t)(hx * 256 + e) * MMEM + b * NMEM + 64 * kt + seg * 8);
            *(LAS u32x4*)(VS + e * VS_STRIDE + seg * 16) = v; }
        __syncthreads();
#pragma unroll
        for (int kb = 0; kb < 2; ++kb)
#pragma unroll
            for (int s = 0; s < 2; ++s) { const bf16x8 a = __builtin_bit_cast(bf16x8, pp[kt * 2 + kb][s]); const int k0 = 32 * kb + 16 * s + 4 * hi;
#pragma unroll
                for (int eb = 0; eb < 8; ++eb) {
                    const u32x2 b0 = *(const LAS u32x2*)(VS + (32 * eb + r32) * VS_STRIDE + k0 * 2), b1 = *(const LAS u32x2*)(VS + (32 * eb + r32) * VS_STRIDE + (k0 + 8) * 2);
                    u32x4 bw; bw.x = b0.x; bw.y = b0.y; bw.z = b1.x; bw.w = b1.y;
                    o[eb] = MFMA32(a, __builtin_bit_cast(bf16x8, bw), o[eb]); } }
        __syncthreads();
    }
    float rl[16];
#pragma unroll
    for (int r = 0; r < 16; ++r) rl[r] = __builtin_amdgcn_rcpf(LL[crow(r, hi)]);
#pragma unroll
    for (int r = 0; r < 16; ++r) { bf16_t* op = ox + (size_t)(m0 + crow(r, hi)) * 1024 + hx * 256 + r32;
#pragma unroll
        for (int eb = 0; eb < 8; ++eb) op[32 * eb] = f2bf(o[eb][r] * rl[r]); }
}
}

struct Args { const float* in[27]; float* out; unsigned char* ws; int ph_lo, ph_hi; };
enum { I_XP = 0, I_XS, I_MP, I_MS, I_LN_MIX_PRE, I_W_IN, I_WA_F, I_BA_F, I_WA_B, I_BA_B, I_GLA_NORM, I_QNORM, I_KNORM, I_W_BR_GLA, I_W_BR_ATT, I_W_OUT, I_LN_MIX_POST,
       I_LN_X_PRE, I_LN_MEM, I_X_WQ, I_X_WKV, I_X_WO, I_LN_X_POST, I_LN_FFN_PRE, I_FFN_WI, I_FFN_WO, I_LN_FFN_POST };

DI void transpose_seg(const float* __restrict__ W, int K, int ldw, int c0, int ncols, bf16_t* __restrict__ WT, int drow0, int mode, float sc, LAS float* scr, int gw, int NGW, int lane) {
    const int nblk = ncols / 32, nitems = (K / 64) * nblk;
    for (int it = gw; it < nitems; it += NGW) {
        const int kb = it / nblk, nb = it % nblk, k0 = 64 * kb, n0 = 32 * nb;
#pragma unroll 8
        for (int i = 0; i < 32; ++i) { const int kk = 2 * i + (lane >> 5); scr[kk * 33 + (lane & 31)] = W[(size_t)(k0 + kk) * ldw + c0 + n0 + (lane & 31)]; }
        asm volatile("s_waitcnt lgkmcnt(0)" ::: "memory");
        const int c = lane & 7;
#pragma unroll
        for (int j = 0; j < 4; ++j) { const int n = (lane >> 3) + 8 * j; const LAS float* s = scr + (8 * c) * 33 + n;
            u32x4 o; o.x = pk2(s[0 * 33] * sc, s[1 * 33] * sc); o.y = pk2(s[2 * 33] * sc, s[3 * 33] * sc); o.z = pk2(s[4 * 33] * sc, s[5 * 33] * sc); o.w = pk2(s[6 * 33] * sc, s[7 * 33] * sc);
            const int cs = n0 + n;
            int drow;
            if (mode == 1) { const int cc = c0 + cs; drow = cc < DFF ? (cc / 128) * 256 + (cc % 128) : ((cc - DFF) / 128) * 256 + 128 + ((cc - DFF) % 128); }
            else drow = drow0 + cs;
            *(u32x4*)(WT + (size_t)drow * K + k0 + 8 * c) = o; }
        asm volatile("s_waitcnt lgkmcnt(0)" ::: "memory");
    }
}
DI void rms_row_to_bf16(const float* __restrict__ xrow, const float* __restrict__ w, bf16_t* __restrict__ orow, int lane) {
    const f32x4* xr = (const f32x4*)xrow + lane; const f32x4* wr = (const f32x4*)w + lane;
    f32x4 v[4]; float s = 0.f;
#pragma unroll
    for (int j = 0; j < 4; ++j) { v[j] = xr[64 * j]; s += (v[j].x * v[j].x + v[j].y * v[j].y) + (v[j].z * v[j].z + v[j].w * v[j].w); }
    const float rstd = rsqrtf(wave_sum(s) * (1.f / 1024.f) + EPS);
    u32x2* o8 = (u32x2*)orow + lane;
#pragma unroll
    for (int j = 0; j < 4; ++j) { const f32x4 g = wr[64 * j]; u32x2 p; p.x = pk2(v[j].x * rstd * g.x, v[j].y * rstd * g.y); p.y = pk2(v[j].z * rstd * g.z, v[j].w * rstd * g.w); o8[64 * j] = p; }
}
DI void norm_res_row(const bf16_t* __restrict__ yrow, const float* __restrict__ base, const float* __restrict__ wpost, float* __restrict__ outrow,
                     const float* __restrict__ wpre, bf16_t* __restrict__ hrow, int lane) {
    const u32x2* yr = (const u32x2*)yrow + lane;
    f32x4 y[4]; float s = 0.f;
#pragma unroll
    for (int j = 0; j < 4; ++j) { const u32x2 p = yr[64 * j]; y[j].x = bf_lo(p.x); y[j].y = bf_hi(p.x); y[j].z = bf_lo(p.y); y[j].w = bf_hi(p.y);
        s += (y[j].x * y[j].x + y[j].y * y[j].y) + (y[j].z * y[j].z + y[j].w * y[j].w); }
    const float rstd = rsqrtf(wave_sum(s) * (1.f / 1024.f) + EPS);
    float s2 = 0.f;
#pragma unroll
    for (int j = 0; j < 4; ++j) { const f32x4 b = ((const f32x4*)base)[lane + 64 * j], g = ((const f32x4*)wpost)[lane + 64 * j];
        y[j] = b + y[j] * rstd * g; ((f32x4*)outrow)[lane + 64 * j] = y[j];
        s2 += (y[j].x * y[j].x + y[j].y * y[j].y) + (y[j].z * y[j].z + y[j].w * y[j].w); }
    if (hrow) {
        const float rstd2 = rsqrtf(wave_sum(s2) * (1.f / 1024.f) + EPS);
#pragma unroll
        for (int j = 0; j < 4; ++j) { const f32x4 g = ((const f32x4*)wpre)[lane + 64 * j]; u32x2 p; p.x = pk2(y[j].x * rstd2 * g.x, y[j].y * rstd2 * g.y); p.y = pk2(y[j].z * rstd2 * g.z, y[j].w * rstd2 * g.w);
            ((u32x2*)hrow)[lane + 64 * j] = p; }
    }
}

#ifndef EN_GLA
#define EN_GLA 1
#endif
#ifndef EN_ATT
#define EN_ATT 1
#endif
#ifndef EN_XAT
#define EN_XAT 1
#endif
#ifndef EN_GEMM
#define EN_GEMM 1
#endif
#ifndef REP_INPROJ
#define REP_INPROJ(r) 1
#endif
#ifndef REP_N1024
#define REP_N1024 1
#endif
constexpr int NPHASE = 14;
struct Ctx {
    LAS unsigned char* lds; int wave, G, bx, gw, NGW;
    const float* const* in; float* out; unsigned char* ws;
};
#define WSP(off) ((bf16_t*)(c.ws + (off)))
#define XROW(m) ((m) < 16 * T ? c.in[I_XP] + (size_t)(m) * 1024 : c.in[I_XS] + (size_t)((m) - 16 * T) * 1024)
#define GEMM(EPI, e, Ap, lda_, Bp, ldb_, M_, N_, K_) do { pg8::Gemm g_{Ap, Bp, M_, N_, K_, lda_, ldb_}; pg8::StaticOrder S_; S_.init(M_, N_, c.G, c.bx); S_.rep = gemm_rep; \
        if (EN_GEMM) pg8::gemm_phase<EPI, pg8::StaticOrder, true, true>(c.lds, g_, S_, e); } while (0)

DI void rms_rows_to_bf16(const Ctx& c, int row0, int nrows, const float* __restrict__ w, bf16_t* __restrict__ dst, int lane, int wv, int nwv) {
    constexpr int NR = 4;
    for (int m0 = wv * NR; m0 < nrows; m0 += nwv * NR) {
        f32x4 v[NR][4]; float s[NR];
#pragma unroll
        for (int k = 0; k < NR; ++k) { const float* xr = XROW(row0 + m0 + k);
#pragma unroll
            for (int j = 0; j < 4; ++j) v[k][j] = ((const f32x4*)xr)[lane + 64 * j]; }
#pragma unroll
        for (int k = 0; k < NR; ++k) { s[k] = 0.f;
#pragma unroll
            for (int j = 0; j < 4; ++j) s[k] += (v[k][j].x * v[k][j].x + v[k][j].y * v[k][j].y) + (v[k][j].z * v[k][j].z + v[k][j].w * v[k][j].w); }
#pragma unroll
        for (int off = 1; off < 64; off <<= 1)
#pragma unroll
            for (int k = 0; k < NR; ++k) s[k] += __shfl_xor(s[k], off);
#pragma unroll
        for (int k = 0; k < NR; ++k) { const float rstd = rsqrtf(s[k] * (1.f / 1024.f) + EPS);
#pragma unroll
            for (int j = 0; j < 4; ++j) { const f32x4 g = ((const f32x4*)w)[lane + 64 * j]; u32x2 p; p.x = pk2(v[k][j].x * rstd * g.x, v[k][j].y * rstd * g.y); p.y = pk2(v[k][j].z * rstd * g.z, v[k][j].w * rstd * g.w);
                ((u32x2*)(dst + (size_t)(m0 + k) * 1024))[lane + 64 * j] = p; } }
    }
}
struct NormP { const bf16_t* Yb; const float* xp; const float* xs; float* out; const float* wpost; const float* wpre; bf16_t* Hb; int first; const bf16_t* Xin; bf16_t* Xout; };
DI void norm_rows(const NormP& P, int row0, int nrows, int wv, int nwv, int lane) {
    constexpr int NR = 4;
    for (int i0 = wv * NR; i0 < nrows; i0 += nwv * NR) {
        const int m0 = row0 + i0;
        u32x2 yp[NR][4]; f32x4 bs[NR][4];
#pragma unroll
        for (int k = 0; k < NR; ++k) { const int m = m0 + k; const float* base = P.first ? (m < 16 * T ? P.xp + (size_t)m * 1024 : P.xs + (size_t)(m - 16 * T) * 1024) : P.out + (size_t)m * 1024;
#pragma unroll
            for (int j = 0; j < 4; ++j) { yp[k][j] = ((const u32x2*)(P.Yb + (size_t)m * 1024))[lane + 64 * j]; bs[k][j] = ((const f32x4*)base)[lane + 64 * j]; } }
        float s[NR];
#pragma unroll
        for (int k = 0; k < NR; ++k) { s[k] = 0.f;
#pragma unroll
            for (int j = 0; j < 4; ++j) { const float a0 = bf_lo(yp[k][j].x), a1 = bf_hi(yp[k][j].x), a2 = bf_lo(yp[k][j].y), a3 = bf_hi(yp[k][j].y); s[k] += (a0 * a0 + a1 * a1) + (a2 * a2 + a3 * a3); } }
#pragma unroll
        for (int off = 1; off < 64; off <<= 1)
#pragma unroll
            for (int k = 0; k < NR; ++k) s[k] += __shfl_xor(s[k], off);
        float s2[NR];
#pragma unroll
        for (int k = 0; k < NR; ++k) { const int m = m0 + k; const float rstd = rsqrtf(s[k] * (1.f / 1024.f) + EPS); s2[k] = 0.f;
#pragma unroll
            for (int j = 0; j < 4; ++j) { const f32x4 g = ((const f32x4*)P.wpost)[lane + 64 * j];
                f32x4 y; y.x = bf_lo(yp[k][j].x); y.y = bf_hi(yp[k][j].x); y.z = bf_lo(yp[k][j].y); y.w = bf_hi(yp[k][j].y);
                bs[k][j] = bs[k][j] + y * rstd * g; ((f32x4*)(P.out + (size_t)m * 1024))[lane + 64 * j] = bs[k][j];
                s2[k] += (bs[k][j].x * bs[k][j].x + bs[k][j].y * bs[k][j].y) + (bs[k][j].z * bs[k][j].z + bs[k][j].w * bs[k][j].w); } }
        if (P.Hb) {
#pragma unroll
            for (int off = 1; off < 64; off <<= 1)
#pragma unroll
                for (int k = 0; k < NR; ++k) s2[k] += __shfl_xor(s2[k], off);
#pragma unroll
            for (int k = 0; k < NR; ++k) { const int m = m0 + k; const float rstd2 = rsqrtf(s2[k] * (1.f / 1024.f) + EPS);
#pragma unroll
                for (int j = 0; j < 4; ++j) { const f32x4 g = ((const f32x4*)P.wpre)[lane + 64 * j]; u32x2 p; p.x = pk2(bs[k][j].x * rstd2 * g.x, bs[k][j].y * rstd2 * g.y); p.y = pk2(bs[k][j].z * rstd2 * g.z, bs[k][j].w * rstd2 * g.w);
                    ((u32x2*)(P.Hb + (size_t)m * 1024))[lane + 64 * j] = p; } }
        }
    }
}
template <int MODE>
struct EpiStoreNorm {
    static constexpr bool FIRST = MODE == 0, XOUT = MODE != 2, HOUT = MODE != 2;
    static constexpr bool PERM = true, AFTER_DRAIN = false, DEFER = true;
    bf16_t* O; unsigned* cnt; NormP P;
    DI void operator()(const f32x4 (&acc)[2][2][4][2], const pg8::Unit& u, int wr, int wc, int fr, int fq) const {
        const __amdgpu_buffer_rsrc_t rs = __builtin_amdgcn_make_buffer_rsrc(O, 0, MTOT * 1024 * 2, 0x00020000);
        const int row0 = u.pm * 256 + wr * 64 + fr, col0 = u.pn * 256 + wc * 32 + 8 * fq;
#pragma unroll
        for (int ai = 0; ai < 2; ++ai)
#pragma unroll
            for (int m = 0; m < 4; ++m) { const unsigned off = (unsigned)(((row0 + ai * 128 + m * 16) * 1024 + col0) * 2);
#pragma unroll
                for (int bj = 0; bj < 2; ++bj) { const f32x4 v0 = acc[ai][bj][m][0], v1 = acc[ai][bj][m][1];
                    u32x4 w; w.x = pk2(v0[0], v0[1]); w.y = pk2(v0[2], v0[3]); w.z = pk2(v1[0], v1[1]); w.w = pk2(v1[2], v1[3]);
                    __builtin_amdgcn_raw_buffer_store_b128(w, rs, off + bj * 256, 0, 16); } }
        asm volatile("s_waitcnt vmcnt(0)" ::: "memory");
        __builtin_amdgcn_s_barrier();
        if (threadIdx.x == 0) __hip_atomic_fetch_add(cnt + 16 * u.pm, 1u, __ATOMIC_RELAXED, __HIP_MEMORY_SCOPE_AGENT);
        if (!stagger()) normpass(u);
    }
    DI bool stagger() const { return ((blockIdx.x >> 3) & 1) != 0; }
    DI void deferred(const pg8::Unit& u) const { if (stagger()) normpass(u); }
    DI void normpass(const pg8::Unit& u) const {
        const int tid = threadIdx.x, lane = tid & 63;
        const int mrow = u.pm * 256 + u.pn * 64 + (tid >> 6) * 8;
        constexpr int NR = 4;
        f32x4 bs[NR][4];
#define NE_LOAD(m, dst) do { if constexpr (FIRST) { const float* b_ = (m) < 16 * T ? P.xp + (size_t)(m) * 1024 : P.xs + (size_t)((m) - 16 * T) * 1024; \
            _Pragma("unroll") for (int j = 0; j < 4; ++j) dst[j] = ((const f32x4*)b_)[lane + 64 * j]; } \
        else { _Pragma("unroll") for (int j = 0; j < 4; ++j) { const u32x2 p_ = ((const u32x2*)(P.Xin + (size_t)(m) * 1024))[lane + 64 * j]; \
            dst[j].x = bf_lo(p_.x); dst[j].y = bf_hi(p_.x); dst[j].z = bf_lo(p_.y); dst[j].w = bf_hi(p_.y); } } } while (0)
#pragma unroll
        for (int k = 0; k < NR; ++k) NE_LOAD(mrow + k, bs[k]);
        f32x4 gpost[4];
#pragma unroll
        for (int j = 0; j < 4; ++j) gpost[j] = ((const f32x4*)P.wpost)[lane + 64 * j];
        asm volatile("s_waitcnt vmcnt(0)" ::: "memory");
        if (tid == 0) { unsigned* cw = cnt + 16 * u.pm;
            unsigned sp = 0;
            while (__hip_atomic_load(cw, __ATOMIC_RELAXED, __HIP_MEMORY_SCOPE_AGENT) < 4u) { __builtin_amdgcn_s_sleep(1); if (++sp > (1u << 22)) break; }
            __builtin_amdgcn_fence(__ATOMIC_ACQUIRE, "agent"); asm volatile("s_waitcnt vmcnt(0)" ::: "memory"); }
        __builtin_amdgcn_s_barrier();
        asm volatile("" ::: "memory");
#pragma unroll
        for (int pass = 0; pass < 2; ++pass) {
            const int mr = mrow + 4 * pass;
            if (pass == 1) {
#pragma unroll
                for (int k = 0; k < NR; ++k) NE_LOAD(mr + k, bs[k]);
            }
            u32x2 yp[NR][4];
#pragma unroll
            for (int k = 0; k < NR; ++k)
#pragma unroll
                for (int j = 0; j < 4; ++j) yp[k][j] = ((const u32x2*)(P.Yb + (size_t)(mr + k) * 1024))[lane + 64 * j];
            float s1[NR];
#pragma unroll
            for (int k = 0; k < NR; ++k) { s1[k] = 0.f;
#pragma unroll
                for (int j = 0; j < 4; ++j) { const float a0 = bf_lo(yp[k][j].x), a1 = bf_hi(yp[k][j].x), a2 = bf_lo(yp[k][j].y), a3 = bf_hi(yp[k][j].y); s1[k] += (a0 * a0 + a1 * a1) + (a2 * a2 + a3 * a3); } }
#pragma unroll
            for (int off = 1; off < 64; off <<= 1)
#pragma unroll
                for (int k = 0; k < NR; ++k) s1[k] += __shfl_xor(s1[k], off);
            float s2[NR];
#pragma unroll
            for (int k = 0; k < NR; ++k) { const int m = mr + k; const float rstd = rsqrtf(s1[k] * (1.f / 1024.f) + EPS); s2[k] = 0.f;
#pragma unroll
                for (int j = 0; j < 4; ++j) { f32x4 y; y.x = bf_lo(yp[k][j].x); y.y = bf_hi(yp[k][j].x); y.z = bf_lo(yp[k][j].y); y.w = bf_hi(yp[k][j].y);
                    bs[k][j] = bs[k][j] + y * rstd * gpost[j];
                    if constexpr (XOUT) { u32x2 q; q.x = pk2(bs[k][j].x, bs[k][j].y); q.y = pk2(bs[k][j].z, bs[k][j].w); ((u32x2*)(P.Xout + (size_t)m * 1024))[lane + 64 * j] = q;
                        bs[k][j].x = bf_lo(q.x); bs[k][j].y = bf_hi(q.x); bs[k][j].z = bf_lo(q.y); bs[k][j].w = bf_hi(q.y); }
                    else ((f32x4*)(P.out + (size_t)m * 1024))[lane + 64 * j] = bs[k][j];
                    s2[k] += (bs[k][j].x * bs[k][j].x + bs[k][j].y * bs[k][j].y) + (bs[k][j].z * bs[k][j].z + bs[k][j].w * bs[k][j].w); } }
            if constexpr (HOUT) {
#pragma unroll
                for (int off = 1; off < 64; off <<= 1)
#pragma unroll
                    for (int k = 0; k < NR; ++k) s2[k] += __shfl_xor(s2[k], off);
#pragma unroll
                for (int k = 0; k < NR; ++k) { const int m = mr + k; const float rstd2 = rsqrtf(s2[k] * (1.f / 1024.f) + EPS);
#pragma unroll
                    for (int j = 0; j < 4; ++j) { const f32x4 gp = ((const f32x4*)P.wpre)[lane + 64 * j]; u32x2 p; p.x = pk2(bs[k][j].x * rstd2 * gp.x, bs[k][j].y * rstd2 * gp.y); p.y = pk2(bs[k][j].z * rstd2 * gp.z, bs[k][j].w * rstd2 * gp.w);
                        ((u32x2*)(P.Hb + (size_t)m * 1024))[lane + 64 * j] = p; } }
            }
        }
#undef NE_LOAD
        asm volatile("s_waitcnt vmcnt(0) lgkmcnt(0)" ::: "memory");
    }
};


template <int MODE>
struct EpiNormReg {
    static constexpr bool FIRST = MODE == 0, HOUT = MODE != 2;
    static constexpr bool PERM = true, AFTER_DRAIN = false, DEFER = false;
    const float* xp; const float* xs; const bf16_t* Xin; bf16_t* Xout; float* outf; bf16_t* Hb; const float* wpost; const float* wpre;
    float* xb1; unsigned* cnt1; float* xb2; unsigned* cnt2; PG8_LAS unsigned char* tl;
    DI void stats(const f32x4 (&v)[2][2][4][2], const pg8::Unit& u, int wr, int wc, int fr, int fq, float* xb, unsigned* cnt) const {
        PG8_LAS float* Pt = (PG8_LAS float*)tl; PG8_LAS float* St = (PG8_LAS float*)(tl + 4096);
        const int tid = threadIdx.x, wid = tid >> 6, lane = tid & 63;
#pragma unroll
        for (int ai = 0; ai < 2; ++ai)
#pragma unroll
            for (int m = 0; m < 4; ++m) { float q = 0.f;
#pragma unroll
                for (int bj = 0; bj < 2; ++bj)
#pragma unroll
                    for (int n = 0; n < 2; ++n) { const f32x4 x = v[ai][bj][m][n]; q += (x[0] * x[0] + x[1] * x[1]) + (x[2] * x[2] + x[3] * x[3]); }
                q += __shfl_xor(q, 16); q += __shfl_xor(q, 32);
                if (fq == 0) Pt[(ai * 128 + wr * 64 + m * 16 + fr) * 4 + wc] = q; }
        asm volatile("s_waitcnt lgkmcnt(0)" ::: "memory"); __builtin_amdgcn_s_barrier(); asm volatile("" ::: "memory");
        if (tid < 256) { const f32x4 p = *(const PG8_LAS f32x4*)(Pt + tid * 4);
            __hip_atomic_store(xb + (size_t)(u.pm * 256 + tid) * 4 + u.pn, (p[0] + p[1]) + (p[2] + p[3]), __ATOMIC_RELAXED, __HIP_MEMORY_SCOPE_AGENT);
            asm volatile("s_waitcnt vmcnt(0)" ::: "memory");
            if (lane == 0) __hip_atomic_fetch_add(cnt + 16 * u.pm, 1u, __ATOMIC_RELAXED, __HIP_MEMORY_SCOPE_AGENT); }
        if (wid == 0) { unsigned sp = 0;
            while ((unsigned)__builtin_amdgcn_readfirstlane(__hip_atomic_load(cnt + 16 * u.pm, __ATOMIC_RELAXED, __HIP_MEMORY_SCOPE_AGENT)) < 16u) { __builtin_amdgcn_s_sleep(1); if (++sp > (1u << 22)) break; }
            __builtin_amdgcn_fence(__ATOMIC_ACQUIRE, "agent"); }
        asm volatile("s_waitcnt vmcnt(0) lgkmcnt(0)" ::: "memory"); __builtin_amdgcn_s_barrier(); asm volatile("" ::: "memory");
        if (tid < 256) { const float* sl = xb + (size_t)(u.pm * 256 + tid) * 4; float t = 0.f;
#pragma unroll
            for (int k = 0; k < 4; ++k) t += __hip_atomic_load(sl + k, __ATOMIC_RELAXED, __HIP_MEMORY_SCOPE_AGENT);
            St[tid] = rsqrtf(t * (1.f / 1024.f) + EPS); }
        asm volatile("s_waitcnt lgkmcnt(0)" ::: "memory"); __builtin_amdgcn_s_barrier(); asm volatile("" ::: "memory");
    }
    DI void operator()(f32x4 (&acc)[2][2][4][2], const pg8::Unit& u, int wr, int wc, int fr, int fq) const {
        PG8_LAS float* St = (PG8_LAS float*)(tl + 4096);
        const int row0 = u.pm * 256 + wr * 64 + fr, col0 = u.pn * 256 + wc * 32 + 8 * fq;
        stats(acc, u, wr, wc, fr, fq, xb1, cnt1);
#pragma unroll
        for (int ai = 0; ai < 2; ++ai)
#pragma unroll
            for (int m = 0; m < 4; ++m) { const int rl = ai * 128 + wr * 64 + m * 16 + fr, row = u.pm * 256 + rl; const float rstd = St[rl];
#pragma unroll
                for (int bj = 0; bj < 2; ++bj) { const int col = col0 + bj * 128;
                    f32x4 b0, b1;
                    if constexpr (FIRST) { const float* bp = (row < 16 * T ? xp + (size_t)row * 1024 : xs + (size_t)(row - 16 * T) * 1024) + col; b0 = *(const f32x4*)bp; b1 = *(const f32x4*)(bp + 4); }
                    else { const u32x4 p = *(const u32x4*)(Xin + (size_t)row * 1024 + col); b0 = (f32x4){bf_lo(p.x), bf_hi(p.x), bf_lo(p.y), bf_hi(p.y)}; b1 = (f32x4){bf_lo(p.z), bf_hi(p.z), bf_lo(p.w), bf_hi(p.w)}; }
                    const f32x4 g0 = *(const f32x4*)(wpost + col), g1 = *(const f32x4*)(wpost + col + 4);
                    f32x4 v0 = b0 + acc[ai][bj][m][0] * rstd * g0, v1 = b1 + acc[ai][bj][m][1] * rstd * g1;
                    if constexpr (MODE == 2) { float* op = outf + (size_t)row * 1024 + col; *(f32x4*)op = v0; *(f32x4*)(op + 4) = v1; }
                    else { u32x4 w; w.x = pk2(v0[0], v0[1]); w.y = pk2(v0[2], v0[3]); w.z = pk2(v1[0], v1[1]); w.w = pk2(v1[2], v1[3]);
                        *(u32x4*)(Xout + (size_t)row * 1024 + col) = w;
                        v0 = (f32x4){bf_lo(w.x), bf_hi(w.x), bf_lo(w.y), bf_hi(w.y)}; v1 = (f32x4){bf_lo(w.z), bf_hi(w.z), bf_lo(w.w), bf_hi(w.w)}; }
                    acc[ai][bj][m][0] = v0; acc[ai][bj][m][1] = v1; }
                if (m & 1) asm volatile("" ::: "memory"); }
        if constexpr (HOUT) {
            stats(acc, u, wr, wc, fr, fq, xb2, cnt2);
#pragma unroll
            for (int ai = 0; ai < 2; ++ai)
#pragma unroll
                for (int m = 0; m < 4; ++m) { const int rl = ai * 128 + wr * 64 + m * 16 + fr, row = u.pm * 256 + rl; const float rstd = St[rl];
#pragma unroll
                    for (int bj = 0; bj < 2; ++bj) { const int col = col0 + bj * 128;
                        const f32x4 g0 = *(const f32x4*)(wpre + col), g1 = *(const f32x4*)(wpre + col + 4);
                        const f32x4 v0 = acc[ai][bj][m][0] * rstd * g0, v1 = acc[ai][bj][m][1] * rstd * g1;
                        u32x4 w; w.x = pk2(v0[0], v0[1]); w.y = pk2(v0[2], v0[3]); w.z = pk2(v1[0], v1[1]); w.w = pk2(v1[2], v1[3]);
                        *(u32x4*)(Hb + (size_t)row * 1024 + col) = w; } }
        }
    }
};
DI void ph_prologue(const Ctx& c) {
    const int tid = tid_opaque(); const int gw = c.gw, NGW = c.NGW, lane = tid & 63;
    LAS float* scr = (LAS float*)(c.lds + c.wave * 16384);
    const float* w_in = c.in[I_W_IN];
    bf16_t* Win_t = WSP(WS_WIN);
    transpose_seg(w_in, 1024, 6688, 0, 1024, Win_t, 0, 0, 1.f, scr, gw, NGW, lane);
    transpose_seg(w_in, 1024, 6688, 2048, 1024, Win_t, 1024, 0, 1.f, scr, gw, NGW, lane);
    transpose_seg(w_in, 1024, 6688, 3104, 1536, Win_t, 2048, 0, 1.f, scr, gw, NGW, lane);
    transpose_seg(w_in, 1024, 6688, 3072, 32, Win_t, 3584, 0, 1.f, scr, gw, NGW, lane);
    transpose_seg(w_in, 1024, 6688, 4640, 2048, Win_t, 3840, 0, 1.f, scr, gw, NGW, lane);
    transpose_seg(w_in, 1024, 6688, 1024, 1024, WSP(WS_WGV), 0, 0, 1.f, scr, gw, NGW, lane);
    for (int i = c.bx * 512 + tid; i < 224 * 1024 / 8; i += c.G * 512) ((u32x4*)(Win_t + (size_t)3616 * 1024))[i] = (u32x4){0u, 0u, 0u, 0u};
    transpose_seg(c.in[I_W_BR_GLA], 1024, 1024, 0, 1024, WSP(WS_WA), 0, 0, 1.f, scr, gw, NGW, lane);
    transpose_seg(c.in[I_W_BR_ATT], 1024, 1024, 0, 1024, WSP(WS_WB), 0, 0, 1.f, scr, gw, NGW, lane);
    transpose_seg(c.in[I_W_OUT], 1024, 1024, 0, 1024, WSP(WS_WOUT), 0, 0, 1.f, scr, gw, NGW, lane);
    transpose_seg(c.in[I_X_WQ], 1024, 1024, 0, 1024, WSP(WS_WQ), 0, 0, 0.0625f, scr, gw, NGW, lane);
    transpose_seg(c.in[I_X_WKV], 1024, 2048, 0, 2048, WSP(WS_WKV), 0, 0, 1.f, scr, gw, NGW, lane);
    transpose_seg(c.in[I_X_WO], 1024, 1024, 0, 1024, WSP(WS_WO), 0, 0, 1.f, scr, gw, NGW, lane);
    transpose_seg(c.in[I_FFN_WI], 1024, 2 * DFF, 0, 2 * DFF, WSP(WS_WI), 0, 1, 1.f, scr, gw, NGW, lane);
    transpose_seg(c.in[I_FFN_WO], DFF, 1024, 0, 1024, WSP(WS_WO2), 0, 0, 1.f, scr, gw, NGW, lane);
    float* TAB = (float*)(c.ws + WS_TAB);
    for (int i = c.bx * 512 + tid; i < 64 * 32; i += c.G * 512) { const int pos = i >> 5, f = i & 31;
        const float inv = powf(10000.f, -(float)(2 * f) / 64.f); const float ang = (float)pos * inv;
        TAB[i] = cosf(ang); TAB[2048 + i] = sinf(ang); }
    bf16_t* MEMN = (bf16_t*)((char*)c.out + 64 * MiB);
    for (int m = gw; m < MMEM; m += NGW) { const float* mr = m < 16 * NMEM ? c.in[I_MP] + (size_t)m * 1024 : c.in[I_MS] + (size_t)(m - 16 * NMEM) * 1024;
        rms_row_to_bf16(mr, c.in[I_LN_MEM], MEMN + (size_t)m * 1024, lane); }
    rms_rows_to_bf16(c, 0, MR, c.in[I_LN_MIX_PRE], WSP(WS_XN), lane, gw, NGW);
}
DI void ph_inproj(const Ctx& c, int r, int gemm_rep) {
    { EpiProj e{WSP(WS_PROJ), WSP(WS_GATES) + (size_t)r * MR * 2048}; GEMM(EpiProj, e, WSP(WS_XN), 1024, WSP(WS_WIN), 1024, MR, N1, 1024); }
    { EpiStore e{WSP(WS_GVT), MR}; GEMM(EpiStore, e, WSP(WS_WGV), 1024, WSP(WS_XN), 1024, 1024, MR, 1024); }
}
DI void ph_memkv(const Ctx& c, int r, int gemm_rep) {
    bf16_t* MEMN = (bf16_t*)((char*)c.out + 64 * MiB) + (size_t)r * 2048 * 1024;
    int bxs = (c.bx + 64) % c.G;
#define GEMM_S(EPI, e, Ap, lda_, Bp, ldb_, M_, N_, K_) do { pg8::Gemm g_{Ap, Bp, M_, N_, K_, lda_, ldb_}; pg8::StaticOrder S_; S_.init(M_, N_, c.G, bxs); S_.rep = gemm_rep; \
        if (EN_GEMM) pg8::gemm_phase<EPI, pg8::StaticOrder, true, true>(c.lds, g_, S_, e); } while (0)
    { EpiStore e{WSP(WS_KMEM) + (size_t)r * 2048 * 1024, 1024}; GEMM_S(EpiStore, e, MEMN, 1024, WSP(WS_WKV), 1024, 2048, 1024, 1024); }
    bxs = (c.bx + 32) % c.G;
    { EpiStore e{WSP(WS_VTMEM) + (size_t)r * 2048, MMEM}; GEMM_S(EpiStore, e, WSP(WS_WKV) + (size_t)1024 * 1024, 1024, MEMN, 1024, 1024, 2048, 1024); }
#undef GEMM_S
}
DI void kprep_item(const Ctx& c, int bl, int ch, int lane) {
    const float* kn = c.in[I_KNORM]; const float* TAB = (const float*)(c.ws + WS_TAB);
    const int sub = lane >> 4, q = lane & 15, blk = q >> 3, fb = (q & 7) * 4;
    const f32x4 g1 = *(const f32x4*)(kn + 64 * blk + fb), g2 = *(const f32x4*)(kn + 64 * blk + 32 + fb);
    constexpr int NIT = 4;
    const int grp0 = (bl * T + ch * 256) * 2 / 4;
    for (int i0 = c.wave * NIT; i0 < 128; i0 += 8 * NIT) {
        u32x2 a[NIT], b[NIT]; bf16_t* pp[NIT]; int tt[NIT];
#pragma unroll
        for (int k = 0; k < NIT; ++k) { const int row = (grp0 + i0 + k) * 4 + sub; const int t = row >> 1, hd = row & 1; tt[k] = t & (T - 1);
            pp[k] = WSP(WS_PROJ) + (size_t)t * LDP + PC_AK + hd * 128 + 64 * blk + fb;
            a[k] = *(const u32x2*)pp[k]; b[k] = *(const u32x2*)(pp[k] + 32); }
#pragma unroll
        for (int k = 0; k < NIT; ++k) {
            float x1[4] = {bf_lo(a[k].x), bf_hi(a[k].x), bf_lo(a[k].y), bf_hi(a[k].y)}, x2[4] = {bf_lo(b[k].x), bf_hi(b[k].x), bf_lo(b[k].y), bf_hi(b[k].y)};
            float ss = (x1[0] * x1[0] + x1[1] * x1[1]) + (x1[2] * x1[2] + x1[3] * x1[3]) + (x2[0] * x2[0] + x2[1] * x2[1]) + (x2[2] * x2[2] + x2[3] * x2[3]);
            ss += __shfl_xor(ss, 1); ss += __shfl_xor(ss, 2); ss += __shfl_xor(ss, 4); ss += __shfl_xor(ss, 8);
            const float rstd = rsqrtf(ss * (1.f / 128.f) + EPS);
            const int pos = blk ? (tt[k] & 63) : (tt[k] >> 6);
            const f32x4 cs = *(const f32x4*)(TAB + pos * 32 + fb), sn = *(const f32x4*)(TAB + 2048 + pos * 32 + fb);
            float o1[4], o2[4];
#pragma unroll
            for (int x = 0; x < 4; ++x) { const float u = x1[x] * rstd * g1[x], v = x2[x] * rstd * g2[x]; o1[x] = u * cs[x] - v * sn[x]; o2[x] = v * cs[x] + u * sn[x]; }
            u32x2 w1, w2; w1.x = pk2(o1[0], o1[1]); w1.y = pk2(o1[2], o1[3]); w2.x = pk2(o2[0], o2[1]); w2.y = pk2(o2[2], o2[3]);
            *(u32x2*)pp[k] = w1; *(u32x2*)(pp[k] + 32) = w2; }
    }
}
DI void combine_item(const Ctx& c, int r, int bl, int tch, int lane) {
    const float* gn = c.in[I_GLA_NORM];
    bf16_t* OFB = WSP(WS_OFB); bf16_t* PROJ = WSP(WS_PROJ); bf16_t* GLA_O = (bf16_t*)c.out;
    const f32x4 g = *(const f32x4*)(gn + lane * 4);
    constexpr int NIT = 8;
    const int base = (bl * T + tch * 64) * 4;
    for (int i0 = c.wave * NIT; i0 < 256; i0 += 8 * NIT) {
        u32x2 a[NIT], b[NIT], rr[NIT];
#pragma unroll
        for (int k = 0; k < NIT; ++k) { const int it = base + i0 + k, t = it >> 2, h = it & 3;
            a[k] = *(const u32x2*)(OFB + (size_t)t * 1024 + h * 256 + lane * 4); b[k] = *(const u32x2*)(OFB + (size_t)(MR + t) * 1024 + h * 256 + lane * 4);
            rr[k] = *(const u32x2*)(PROJ + (size_t)t * LDP + PC_GR + h * 256 + lane * 4); }
        float o[NIT][4], ss[NIT];
#pragma unroll
        for (int k = 0; k < NIT; ++k) { o[k][0] = bf_lo(a[k].x) + bf_lo(b[k].x); o[k][1] = bf_hi(a[k].x) + bf_hi(b[k].x); o[k][2] = bf_lo(a[k].y) + bf_lo(b[k].y); o[k][3] = bf_hi(a[k].y) + bf_hi(b[k].y);
            ss[k] = (o[k][0] * o[k][0] + o[k][1] * o[k][1]) + (o[k][2] * o[k][2] + o[k][3] * o[k][3]); }
#pragma unroll
        for (int off = 1; off < 64; off <<= 1)
#pragma unroll
            for (int k = 0; k < NIT; ++k) ss[k] += __shfl_xor(ss[k], off);
#pragma unroll
        for (int k = 0; k < NIT; ++k) { const int it = base + i0 + k, t = it >> 2, h = it & 3;
            const float rstd = rsqrtf(ss[k] * (1.f / 256.f) + EPS);
            const float rv[4] = {bf_lo(rr[k].x), bf_hi(rr[k].x), bf_lo(rr[k].y), bf_hi(rr[k].y)};
            float v[4];
#pragma unroll
            for (int j = 0; j < 4; ++j) v[j] = o[k][j] * rstd * g[j] * (rv[j] * sigmoidf_(rv[j]));
            u32x2 w; w.x = pk2(v[0], v[1]); w.y = pk2(v[2], v[3]);
            *(u32x2*)(GLA_O + (size_t)(r * MR + t) * 1024 + h * 256 + lane * 4) = w; }
    }
}
DI void ph_mixers(const Ctx& c, int r) {
    const int tid = tid_opaque();
    LAS int* qslot = (LAS int*)(c.lds + LDS_MISC);
    unsigned* CTL = (unsigned*)(c.ws + WS_CTL);
    bf16_t* PROJ = WSP(WS_PROJ); bf16_t* ATT_O = (bf16_t*)c.out + (size_t)MTOT * 1024;
    for (;;) {
        __syncthreads();
        if (tid == 0) *qslot = (int)atomicAdd(CTL + 64 * (1 + 2 * r), 1u);
        __syncthreads();
        const int it = *qslot;
        if (it >= 64) break;
        const int bl = it >> 3, h = (it >> 1) & 3, dir = it & 1;
        if (EN_GLA) gla::item((LAS char*)c.lds, PROJ, WSP(WS_GVT), WSP(WS_OFB) + (size_t)dir * MR * 1024, c.in[dir ? I_WA_B : I_WA_F], c.in[dir ? I_BA_B : I_BA_F], bl, h, dir);
        asm volatile("s_waitcnt vmcnt(0)" ::: "memory");
        __syncthreads();
        if (tid == 0) { __builtin_amdgcn_fence(__ATOMIC_RELEASE, "agent"); asm volatile("s_waitcnt vmcnt(0)" ::: "memory");
            __hip_atomic_fetch_add(CTL + 1024 + r * 8 + bl, 1u, __ATOMIC_RELAXED, __HIP_MEMORY_SCOPE_AGENT); }
    }
    for (;;) {
        __syncthreads();
        if (tid == 0) *qslot = (int)atomicAdd(CTL + 64 * (10 + r), 1u);
        __syncthreads();
        const int it = *qslot;
        if (it >= 64) break;
        kprep_item(c, it >> 3, it & 7, tid & 63);
        asm volatile("s_waitcnt vmcnt(0)" ::: "memory");
        __syncthreads();
        if (tid == 0) { __builtin_amdgcn_fence(__ATOMIC_RELEASE, "agent"); asm volatile("s_waitcnt vmcnt(0)" ::: "memory");
            __hip_atomic_fetch_add(CTL + 1088 + r * 8 + (it >> 3), 1u, __ATOMIC_RELAXED, __HIP_MEMORY_SCOPE_AGENT); }
    }
    const int myx = (int)((unsigned)__builtin_amdgcn_s_getreg((3 << 11) | 20) & 7u);
    for (int kq = 0; kq < 8; ++kq) {
        const int qx = (myx + kq) & 7;
        for (;;) {
            __syncthreads();
            if (tid == 0) *qslot = (int)atomicAdd(CTL + 2048 + (r * 8 + qx) * 64, 1u);
            __syncthreads();
            const int uq = *qslot;
            if (uq >= 64) break;
            const int u = qx * 64 + uq;
            const int bl = u >> 6, hq = (u >> 3) & 7, qb = u & 7, kvh = hq >> 2;
            if (tid == 0) { while (__hip_atomic_load(CTL + 1088 + r * 8 + bl, __ATOMIC_RELAXED, __HIP_MEMORY_SCOPE_AGENT) < 8u) __builtin_amdgcn_s_sleep(2);
                __builtin_amdgcn_fence(__ATOMIC_ACQUIRE, "agent"); asm volatile("s_waitcnt vmcnt(0)" ::: "memory"); }
            __syncthreads();
            const bf16_t* pb = PROJ + (size_t)(bl * T) * LDP;
            if (EN_ATT) att::attn_dense_body<LDP, LDP, 1024>(pb + (size_t)(qb * 256) * LDP + PC_AQ + hq * 128, pb + PC_AK + kvh * 128, pb + PC_AV + kvh * 128,
                                                 ATT_O + (size_t)(r * MR + bl * T + qb * 256) * 1024 + hq * 128, T, (LAS char*)c.lds, c.in[I_QNORM], (const float*)(c.ws + WS_TAB), qb * 256);
        }
    }
    const int lane = tid & 63;
    const int nxn = (r < 2 ? 64 : 0), nlight = nxn + 256;
    for (;;) {
        __syncthreads();
        if (tid == 0) *qslot = (int)atomicAdd(CTL + 64 * (7 + r), 1u);
        __syncthreads();
        const int it = *qslot;
        if (it >= nlight) break;
        if (it < nxn) {
            rms_rows_to_bf16(c, (r + 1) * MR + it * 256, 256, c.in[I_LN_MIX_PRE], WSP(WS_XN) + (size_t)it * 256 * 1024, lane, c.wave, 8);
        } else { const int ci = it - nxn, bl = ci >> 5, tch = ci & 31;
            if (tid == 0) { while (__hip_atomic_load(CTL + 1024 + r * 8 + bl, __ATOMIC_RELAXED, __HIP_MEMORY_SCOPE_AGENT) < 8u) __builtin_amdgcn_s_sleep(4);
                __builtin_amdgcn_fence(__ATOMIC_ACQUIRE, "agent"); asm volatile("s_waitcnt vmcnt(0)" ::: "memory"); }
            __syncthreads();
            combine_item(c, r, bl, tch, lane);
        }
    }
}
DI void ph_cross(const Ctx& c) {
    for (int u = c.bx; u < NBATCH * 4 * 8; u += c.G) { const int b = u >> 5, hx = (u >> 3) & 3, qb = u & 7;
        if (EN_XAT) xat::unit((LAS char*)c.lds, WSP(WS_QX), WSP(WS_KMEM), WSP(WS_VTMEM), WSP(WS_OX), b, hx, qb); }
}

#define XB_TMO      128
#define XB_XCNT(j)  (256  + 64 * (j))
#define XB_XSUB(j)  (1280 + 64 * (j))
#define XB_XGEN(j)  (2304 + 64 * (j))
#define XB_TOP      3328
#define XB_TOPGEN   3392
#define XCD_BAR_WORDS 3456
#define XB_SPIN_CAP (1u << 22)
DI unsigned xb_ld(unsigned* p)              { return __hip_atomic_load(p, __ATOMIC_RELAXED, __HIP_MEMORY_SCOPE_AGENT); }
DI unsigned xb_add(unsigned* p, unsigned v) { return __hip_atomic_fetch_add(p, v, __ATOMIC_RELAXED, __HIP_MEMORY_SCOPE_AGENT); }
DI unsigned xb_xcc_id() { return (unsigned)__builtin_amdgcn_s_getreg((3 << 11) | 20) & 0xFu; }
#define XB_SPIN(cond, bar) do { unsigned _sp = 0; while (cond) { __builtin_amdgcn_s_sleep(1); \
    if ((++_sp & 255u) == 0u) { if (xb_ld(&(bar)[XB_TMO])) break; if (_sp > XB_SPIN_CAP) { atomicAdd(&(bar)[XB_TMO], 1u); break; } } } } while (0)
struct XcdBarrier { unsigned* bar; unsigned x; volatile LAS unsigned* st; };
DI XcdBarrier xcd_barrier_post(unsigned* bar, volatile LAS unsigned* st) {
    XcdBarrier b; b.bar = bar; b.x = xb_xcc_id(); b.st = st;
    if (threadIdx.x == 0) (void)xb_add(&bar[XB_XCNT(b.x)], 1u);
    return b;
}
DI void xcd_barrier_complete(unsigned* bar, unsigned x, unsigned& nloc, unsigned& nx) {
    const unsigned G = gridDim.x * gridDim.y * gridDim.z;
    unsigned sum, cnt, mine, sp = 0u;
    for (;;) {
        sum = 0u; cnt = 0u; mine = 0u;
#pragma unroll
        for (unsigned j = 0; j < 16; ++j) { const unsigned c = xb_ld(&bar[XB_XCNT(j)]); sum += c; cnt += (c > 0u) ? 1u : 0u; mine = (j == x) ? c : mine; }
        if (sum == G) break;
        __builtin_amdgcn_s_sleep(1);
        if ((++sp & 255u) == 0u) { if (xb_ld(&bar[XB_TMO])) break; if (sp > XB_SPIN_CAP) { atomicAdd(&bar[XB_TMO], 1u); break; } }
    }
    nloc = mine > 0u ? mine : 1u; nx = cnt > 0u ? cnt : 1u;
}
DI void xcd_barrier(const XcdBarrier& b) {
    asm volatile("s_waitcnt vmcnt(0)" ::: "memory");
    __syncthreads();
    if (threadIdx.x == 0) {
        unsigned* bar = b.bar;
        __builtin_amdgcn_s_waitcnt(0);
        unsigned nloc = b.st[0], nx = b.st[1];
        if (nloc == 0u) { xcd_barrier_complete(bar, b.x, nloc, nx); b.st[0] = nloc; b.st[1] = nx; }
        const unsigned old = xb_add(&bar[XB_XSUB(b.x)], 1u);
        const unsigned gen = old / nloc;
        if (old + 1u == (gen + 1u) * nloc) {
            __builtin_amdgcn_fence(__ATOMIC_RELEASE, "agent");
            asm volatile("s_waitcnt vmcnt(0)" ::: "memory");
            const unsigned og = xb_add(&bar[XB_TOP], 1u);
            const unsigned tg = og / nx;
            if (og + 1u == (tg + 1u) * nx) xb_add(&bar[XB_TOPGEN], 1u);
            else XB_SPIN(xb_ld(&bar[XB_TOPGEN]) == tg, bar);
            __builtin_amdgcn_fence(__ATOMIC_ACQUIRE, "agent");
            xb_add(&bar[XB_XGEN(b.x)], 1u);
            asm volatile("s_waitcnt vmcnt(0)" ::: "memory");
        } else {
            XB_SPIN(xb_ld(&bar[XB_XGEN(b.x)]) == gen, bar);
            __builtin_amdgcn_fence(__ATOMIC_ACQUIRE, "agent");
            asm volatile("s_waitcnt vmcnt(0)" ::: "memory");
        }
    }
    __syncthreads();
}
DI void grid_bar(unsigned* ctr, unsigned target) {
    asm volatile("s_waitcnt vmcnt(0)" ::: "memory");
    __syncthreads();
    if (threadIdx.x == 0) {
        __builtin_amdgcn_fence(__ATOMIC_RELEASE, "agent");
        asm volatile("s_waitcnt vmcnt(0)" ::: "memory");
        __hip_atomic_fetch_add(ctr, 1u, __ATOMIC_RELAXED, __HIP_MEMORY_SCOPE_AGENT);
        while (__hip_atomic_load(ctr, __ATOMIC_RELAXED, __HIP_MEMORY_SCOPE_AGENT) < target) __builtin_amdgcn_s_sleep(2);
        __builtin_amdgcn_fence(__ATOMIC_ACQUIRE, "agent");
        asm volatile("s_waitcnt vmcnt(0)" ::: "memory");
    }
    __syncthreads();
}
__global__ void __launch_bounds__(512) fwd(Args args) {
    extern __shared__ __attribute__((aligned(16))) unsigned char lds_raw[];
    Ctx c;
    c.lds = (LAS unsigned char*)lds_raw;
    c.wave = __builtin_amdgcn_readfirstlane(threadIdx.x >> 6);
    c.G = gridDim.x; c.bx = blockIdx.x; c.gw = c.bx * 8 + c.wave; c.NGW = c.G * 8;
    c.in = args.in; c.out = args.out; c.ws = args.ws;
    cg::grid_group grid = cg::this_grid();
    const int lo = args.ph_lo, hi = args.ph_hi;
    volatile LAS unsigned* xst = (volatile LAS unsigned*)(c.lds + LDS_MISC + 128);
    if (threadIdx.x < 2) xst[threadIdx.x] = 0u;
    __syncthreads();
    XcdBarrier xbar; xbar.bar = (unsigned*)(c.ws + WS_CTL) + 4096; xbar.x = 0; xbar.st = xst;
    if (hi - lo > 1) xbar = xcd_barrier_post((unsigned*)(c.ws + WS_CTL) + 4096, xst);
    int gemm_rep = 1;
#define IN(k) (lo <= (k) && (k) < hi)
#define SEAM(k) do { if (IN(k) && IN((k) + 1)) { if (args.ph_hi < 0) grid.sync(); else xcd_barrier(xbar); } } while (0)
    if (IN(0)) ph_prologue(c);
    SEAM(0);
#define ROUND(r) \
    if (IN(1 + 2 * (r))) { ph_inproj(c, r, REP_INPROJ(r)); ph_memkv(c, r, REP_INPROJ(r)); } SEAM(1 + 2 * (r)); \
    if (IN(2 + 2 * (r))) ph_mixers(c, r); SEAM(2 + 2 * (r));
    ROUND(0) ROUND(1) ROUND(2)
    if (IN(7)) { EpiGate e{WSP(WS_GATES), 0}; GEMM(EpiGate, e, (bf16_t*)c.out, 1024, WSP(WS_WA), 1024, MTOT, 1024, 1024);
        asm volatile("s_waitcnt vmcnt(0)" ::: "memory"); __syncthreads();
        if (threadIdx.x == 0) { __builtin_amdgcn_fence(__ATOMIC_ACQUIRE, "agent"); asm volatile("s_waitcnt vmcnt(0)" ::: "memory"); }
        __syncthreads();
        EpiGate e2{WSP(WS_GATES), 1}; GEMM(EpiGate, e2, (bf16_t*)c.out + (size_t)MTOT * 1024, 1024, WSP(WS_WB), 1024, MTOT, 1024, 1024); }
    SEAM(7);
    bf16_t* XB1 = (bf16_t*)c.out; bf16_t* XB2 = WSP(408 * MiB); bf16_t* H3 = WSP(312 * MiB); bf16_t* Y2 = WSP(48 * MiB); bf16_t* Y3 = WSP(312 * MiB);
#define NREG(MODE_, cb, wpost_, wpre_, Hp, Xin_, Xout_) EpiNormReg<MODE_>{c.in[I_XP], c.in[I_XS], Xin_, Xout_, c.out, Hp, wpost_, wpre_, \
        (float*)(c.ws + WS_CTL + 131072), (unsigned*)(c.ws + WS_CTL) + (cb), (float*)((char*)c.out + 96 * MiB), (unsigned*)(c.ws + WS_CTL) + (cb) + 3072, (PG8_LAS unsigned char*)(c.lds + 131072 + 8192)}
    if (IN(8)) { EpiNormReg<0> e = NREG(0, 8192, c.in[I_LN_MIX_POST], c.in[I_LN_X_PRE], WSP(WS_H), nullptr, XB1); GEMM(EpiNormReg<0>, e, WSP(WS_GATES), 2048, WSP(WS_WOUT), 1024, MTOT, 1024, 1024); } SEAM(8);
    gemm_rep = REP_N1024; if (IN(9)) { EpiStore e{WSP(WS_QX), 1024}; GEMM(EpiStore, e, WSP(WS_H), 1024, WSP(WS_WQ), 1024, MTOT, 1024, 1024); } gemm_rep = 1; SEAM(9);
    if (IN(10)) ph_cross(c); SEAM(10);
    if (IN(11)) { EpiNormReg<1> e = NREG(1, 8192 + 6144, c.in[I_LN_X_POST], c.in[I_LN_FFN_PRE], H3, XB1, XB2); GEMM(EpiNormReg<1>, e, WSP(WS_OX), 1024, WSP(WS_WO), 1024, MTOT, 1024, 1024); } SEAM(11);
    if (IN(12)) { EpiSwiglu e{WSP(WS_ACT)}; GEMM(EpiSwiglu, e, H3, 1024, WSP(WS_WI), 1024, MTOT, 2 * DFF, 1024); } SEAM(12);
    if (IN(13)) { EpiNormReg<2> e = NREG(2, 8192 + 12288, c.in[I_LN_FFN_POST], nullptr, nullptr, XB2, nullptr); GEMM(EpiNormReg<2>, e, WSP(WS_ACT), DFF, WSP(WS_WO2), DFF, MTOT, 1024, DFF); }
}

#ifndef N_LAUNCH_MODE
#define N_LAUNCH_MODE 0
#endif
extern "C" void kernel_launch(void* const* d_in, const int* in_sizes, int n_in, void* d_out, int out_size, void* d_ws, size_t ws_size, hipStream_t stream) {
    static int grid = 0;
    if (grid == 0) {
        if (n_in != 27 || out_size != MTOT * 1024 || ws_size < WS_END) { fprintf(stderr, "kernel_launch: unexpected shapes: n_in %d out %d ws %zu (need %zu)\n", n_in, out_size, ws_size, (size_t)WS_END); grid = -1; return; }
        int dev = 0, cus = 0, per_cu = 0;
        hipGetDevice(&dev); hipDeviceGetAttribute(&cus, hipDeviceAttributeMultiprocessorCount, dev);
        if (hipFuncSetAttribute((const void*)fwd, hipFuncAttributeMaxDynamicSharedMemorySize, LDS_BYTES) != hipSuccess) { fprintf(stderr, "kernel_launch: hipFuncSetAttribute failed\n"); grid = -1; return; }
        if (hipOccupancyMaxActiveBlocksPerMultiprocessor(&per_cu, (const void*)fwd, 512, LDS_BYTES) != hipSuccess || per_cu < 1) { fprintf(stderr, "kernel_launch: occupancy query says %d\n", per_cu); per_cu = 1; }
        (void)hipGetLastError();
        grid = cus * 1;
    }
    if (grid < 0) return;
    hipMemsetAsync((char*)d_ws + WS_CTL, 0, 131072, stream);
    Args a{};
    for (int i = 0; i < 27; ++i) a.in[i] = (const float*)d_in[i];
    a.out = (float*)d_out; a.ws = (unsigned char*)d_ws;
#if N_LAUNCH_MODE == 0
    a.ph_lo = 0; a.ph_hi = NPHASE;
    void* kargs[] = {&a};
    hipError_t e = hipLaunchCooperativeKernel((const void*)fwd, dim3(grid), dim3(512), kargs, LDS_BYTES, stream);
    if (e != hipSuccess) fprintf(stderr, "cooperative launch failed: %s (grid %d)\n", hipGetErrorString(e), grid);
#else
    for (int ph = 0; ph < NPHASE; ++ph) { a.ph_lo = ph; a.ph_hi = ph + 1; hipLaunchKernelGGL(fwd, dim3(grid), dim3(512), LDS_BYTES, stream, a); }
    hipError_t e = hipPeekAtLastError();
    if (e != hipSuccess) fprintf(stderr, "launch failed: %s\n", hipGetErrorString(e));
#endif
}
```

```cpp
#include <hip/hip_runtime.h>
#include <hip/hip_cooperative_groups.h>
#include <cstdio>
#include <cstdint>
namespace cg = cooperative_groups;

#define LAS __attribute__((address_space(3)))
typedef unsigned short bf16_t;
typedef short bf16x8 __attribute__((ext_vector_type(8)));
typedef float f32x2 __attribute__((ext_vector_type(2)));
typedef float f32x4 __attribute__((ext_vector_type(4)));
typedef float f32x16 __attribute__((ext_vector_type(16)));
typedef unsigned u32x2 __attribute__((ext_vector_type(2)));
typedef unsigned u32x4 __attribute__((ext_vector_type(4)));
typedef __bf16 bf16v2 __attribute__((ext_vector_type(2)));
#define DI __device__ __forceinline__
#define MFMA32(a, b, c) __builtin_amdgcn_mfma_f32_32x32x16_bf16((a), (b), (c), 0, 0, 0)

DI unsigned pk2(float lo, float hi) { f32x2 v = {lo, hi}; bf16v2 r = __builtin_convertvector(v, bf16v2); return __builtin_bit_cast(unsigned, r); }
DI bf16_t f2bf(float f) { return (bf16_t)(pk2(f, 0.f) & 0xffffu); }
DI float bf_lo(unsigned u) { return __uint_as_float(u << 16); }
DI float bf_hi(unsigned u) { return __uint_as_float(u & 0xffff0000u); }
DI float bf2f(bf16_t v) { return __uint_as_float(((unsigned)v) << 16); }
DI float sigmoidf_(float v) { return __builtin_amdgcn_rcpf(1.f + __expf(-v)); }
DI int tid_opaque() { int t = threadIdx.x; asm volatile("" : "+v"(t)); return t; }
DI int crow(int r, int hi) { return (r & 3) + 8 * (r >> 2) + 4 * hi; }
DI float wave_sum(float v) {
#pragma unroll
    for (int o = 1; o < 64; o <<= 1) v += __shfl_xor(v, o);
    return v;
}

constexpr int DM = 1024, NBATCH = 24, T = 2048, MTOT = NBATCH * T, RB = 8, MR = RB * T, NROUND = 3, NMEM = 256, MMEM = NBATCH * NMEM;
constexpr int DFF = 2816;
constexpr int LDP = 3840;
constexpr int PC_GQ = 0, PC_GK = 512, PC_GR = 1024, PC_AQ = 2048, PC_AK = 3072, PC_AV = 3328, PC_Z = 3584;
constexpr int NPROJ_TILES = 15, N1 = 23 * 256;
constexpr float EPS = 1e-6f;
constexpr size_t MiB = 1u << 20;
constexpr size_t WS_CTL = 0;
constexpr size_t WS_WIN = 1 * MiB;
constexpr size_t WS_WGV = WS_WIN + (size_t)N1 * 1024 * 2;
constexpr size_t WS_WA = WS_WGV + 2 * MiB, WS_WB = WS_WA + 2 * MiB, WS_WOUT = WS_WB + 2 * MiB, WS_WQ = WS_WOUT + 2 * MiB;
constexpr size_t WS_WKV = WS_WQ + 2 * MiB, WS_WO = WS_WKV + 4 * MiB, WS_WI = WS_WO + 2 * MiB, WS_WO2 = WS_WI + 11 * MiB;
constexpr size_t WS_TAB = WS_WO2 + 6 * MiB;
static_assert(WS_TAB + 65536 <= 48 * MiB, "weights region");
constexpr size_t WS_R = 48 * MiB;
constexpr size_t WS_GATES = WS_R;
constexpr size_t WS_PROJ = WS_R + 192 * MiB;
constexpr size_t WS_GVT = WS_PROJ + 120 * MiB;
constexpr size_t WS_XN = WS_GVT + 32 * MiB;
constexpr size_t WS_OFB = WS_XN + 32 * MiB;
constexpr size_t WS_KMEM = WS_OFB + 64 * MiB;
constexpr size_t WS_VTMEM = WS_KMEM + 12 * MiB;
constexpr size_t WS_END = WS_VTMEM + 12 * MiB;
static_assert(WS_END == 512 * MiB, "ws map");
constexpr size_t WS_Y = WS_R + 192 * MiB;
constexpr size_t WS_H = WS_R + 288 * MiB;
constexpr size_t WS_QX = WS_R;
constexpr size_t WS_OX = WS_R + 96 * MiB;
constexpr size_t WS_ACT = WS_R;
static_assert(WS_ACT + (size_t)MTOT * DFF * 2 <= WS_H, "act overlay");
static_assert(WS_H + 96 * MiB <= WS_KMEM, "H overlay");
constexpr int LDS_BYTES = 147456;
constexpr int LDS_MISC = 147456 - 256;

namespace pg8 {
#define PG8_LAS __attribute__((address_space(3)))
constexpr int BM = 256, BK = 64, HALF = 128, HTB = HALF * BK * 2, STAGE_BYTES = 8 * HTB, NXCD = 8, WGM = 8;
__host__ __device__ __forceinline__ int lds_byte(int r, int c) { const int st = (r >> 4) * 2 + (c >> 5), rr = r & 15, cc = c & 31, ob = rr * 64 + cc * 2; return st * 1024 + (ob ^ (((ob >> 9) & 1) << 5)); }
__host__ __device__ __forceinline__ void stage_rc(int b, int& R, int& C) { const int st = b / 1024, sb = b % 1024, swz = sb ^ (((sb >> 9) & 1) << 5); R = (st >> 1) * 16 + swz / 64; C = (st & 1) * 32 + (swz % 64) / 2; }
__host__ __device__ __forceinline__ int perm32(int rho) { const int n = rho >> 4, i = rho & 15; return 8 * (i >> 2) + 4 * n + (i & 3); }
struct Unit { int pm, pn; };
struct Gemm { const bf16_t* A; const bf16_t* Bt; int M, N, K, lda, ldb; };
struct StaticOrder {
    int nM, nN, nwg, G, c, rep = 1;
    __host__ __device__ void init(int M, int N, int G_, int c_) { nM = M / BM; nN = N / BM; nwg = nM * nN; G = G_; c = c_; }
    __host__ __device__ bool next(int i, Unit& u) const {
        const long L = (long)i * G + c; if (L >= (long)nwg * rep) return false;
        int wgid = (int)(L % nwg); { const int q = nwg / NXCD, r = nwg % NXCD, xcd = wgid % NXCD, off = wgid / NXCD; wgid = (xcd < r ? xcd * (q + 1) : r * (q + 1) + (xcd - r) * q) + off; }
        const int nig = WGM * nN, gid = wgid / nig, fm = gid * WGM, gsz = (nM - fm) < WGM ? (nM - fm) : WGM;
        u.pm = fm + ((wgid % nig) % gsz); u.pn = (wgid % nig) / gsz; return true;
    }
    __device__ __forceinline__ void a_ready(const Unit&) const {}
    __device__ __forceinline__ void done(const Unit&) const {}
};
template <class Epi, class Sched, bool ALIGN_EPI = false, bool SP2 = false>
__device__ __forceinline__ void gemm_phase(PG8_LAS unsigned char* lds, const Gemm g, const Sched& S, const Epi& E) {
    const int tid = threadIdx.x, wid = __builtin_amdgcn_readfirstlane(tid >> 6), lane = tid & 63, wr = wid >> 2, wc = wid & 3, fr = lane & 15, fq = lane >> 4;
    const int K = g.K, nt = K / BK;
    unsigned voffA[2], voffB[2];
#pragma unroll
    for (int i = 0; i < 2; ++i) { int R, C; stage_rc(tid * 16 + i * 8192, R, C); const int Rb = Epi::PERM ? ((R & ~31) + perm32(R & 31)) : R;
        voffA[i] = (unsigned)(R * g.lda + C) * 2u; voffB[i] = (unsigned)(Rb * g.ldb + C) * 2u; }
    const size_t kstep = (size_t)(BK * 2);
    const size_t hstepA = (size_t)HALF * g.lda * 2, hstepB = (size_t)HALF * g.ldb * 2;
    const size_t tstepA = 2 * hstepA, tstepB = 2 * hstepB;
    const unsigned ldsw = (unsigned)wid * 1024u;
    const int aoff = lds_byte(wr * 64 + fr, fq * 8), boff = lds_byte(wc * 32 + fr, fq * 8);
#define PG8_SA(b, h) (((b) * 2 + (h)) * HTB)
#define PG8_SB(b, h) ((4 + (b) * 2 + (h)) * HTB)
#define PG8_STAGE(bufoff, gbase, voff) do { _Pragma("unroll") for (int _i = 0; _i < 2; ++_i) \
        __builtin_amdgcn_global_load_lds((const unsigned*)((const char*)(gbase) + (voff)[_i]), (PG8_LAS unsigned*)(lds + (bufoff) + ldsw + _i * 8192), 16, 0, 0); } while (0)
#define PG8_LDA(dst, b, h) do { _Pragma("unroll") for (int m = 0; m < 4; ++m) _Pragma("unroll") for (int k = 0; k < 2; ++k) dst[m][k] = *(const PG8_LAS bf16x8*)(lds + PG8_SA(b, h) + aoff + m * 2048 + k * 1024); } while (0)
#define PG8_LDB(dst, b, h) do { _Pragma("unroll") for (int n = 0; n < 2; ++n) _Pragma("unroll") for (int k = 0; k < 2; ++k) dst[n][k] = *(const PG8_LAS bf16x8*)(lds + PG8_SB(b, h) + boff + n * 2048 + k * 1024); } while (0)
#define PG8_MMA(ai, bj, At, Bt) do { __builtin_amdgcn_s_setprio(1); _Pragma("unroll") for (int m = 0; m < 4; ++m) _Pragma("unroll") for (int n = 0; n < 2; ++n) _Pragma("unroll") for (int k = 0; k < 2; ++k) \
        acc[ai][bj][m][n] = __builtin_amdgcn_mfma_f32_16x16x32_bf16(Bt[n][k], At[m][k], acc[ai][bj][m][n], 0, 0, 0); __builtin_amdgcn_s_setprio(0); } while (0)
#define PG8_WAIT_V(n) asm volatile("s_waitcnt vmcnt(" #n ")" ::: "memory")
#define PG8_WAIT_L(n) asm volatile("s_waitcnt lgkmcnt(" #n ")" ::: "memory")
#define PG8_BAR __builtin_amdgcn_s_barrier()
#define PG8_SCHED __builtin_amdgcn_sched_barrier(0)
    Unit cur, nxt, prv; int ui = 0; bool has_prv = false;
    if (!S.next(0, cur)) return;
    f32x4 acc[2][2][4][2];
#pragma unroll
    for (int a = 0; a < 2; ++a)
#pragma unroll
        for (int b = 0; b < 2; ++b)
#pragma unroll
            for (int m = 0; m < 4; ++m)
#pragma unroll
                for (int n = 0; n < 2; ++n) acc[a][b][m][n] = (f32x4){0.f, 0.f, 0.f, 0.f};
    bf16x8 At[4][2], B0[2][2], B1[2][2];
    const char* cA = (const char*)g.A + (size_t)cur.pm * tstepA; const char* cB = (const char*)g.Bt + (size_t)cur.pn * tstepB;
    S.a_ready(cur);
    if constexpr (SP2) {
        PG8_STAGE(PG8_SB(0, 0), cB, voffB); PG8_STAGE(PG8_SB(0, 1), cB + hstepB, voffB); PG8_STAGE(PG8_SA(0, 0), cA, voffA); PG8_STAGE(PG8_SA(0, 1), cA + hstepA, voffA);
        if (wr == 1) PG8_BAR;
        PG8_WAIT_V(2); PG8_BAR;
        PG8_STAGE(PG8_SB(1, 0), cB + kstep, voffB); PG8_STAGE(PG8_SA(1, 0), cA + kstep, voffA); PG8_STAGE(PG8_SB(1, 1), cB + hstepB + kstep, voffB);
        PG8_WAIT_V(6); PG8_BAR;
    } else {
        PG8_STAGE(PG8_SB(0, 0), cB, voffB); PG8_STAGE(PG8_SA(0, 0), cA, voffA); PG8_STAGE(PG8_SB(0, 1), cB + hstepB, voffB); PG8_STAGE(PG8_SA(0, 1), cA + hstepA, voffA);
        if (wr == 1) PG8_BAR;
        PG8_WAIT_V(4); PG8_BAR;
        PG8_STAGE(PG8_SB(1, 0), cB + kstep, voffB); PG8_STAGE(PG8_SA(1, 0), cA + kstep, voffA); PG8_STAGE(PG8_SB(1, 1), cB + hstepB + kstep, voffB);
        PG8_WAIT_V(6); PG8_BAR;
    }
    for (;;) {
        const bool has_next = S.next(ui + 1, nxt);
        const char* nA = has_next ? (const char*)g.A + (size_t)nxt.pm * tstepA : cA; const char* nB = has_next ? (const char*)g.Bt + (size_t)nxt.pn * tstepB : cB;
        for (int t = 0; t < nt; t += 2) {
            const bool last = (t == nt - 2);
            const char* a1 = cA + (size_t)(t + 1) * kstep;
            const char* a2 = last ? nA : cA + (size_t)(t + 2) * kstep; const char* b2 = last ? nB : cB + (size_t)(t + 2) * kstep;
            const char* a3 = a2 + kstep; const char* b3 = b2 + kstep;
            if (last && has_next) S.a_ready(nxt);
            if constexpr (SP2) {
            PG8_LDB(B0, 0, 0); PG8_LDB(B1, 0, 1); PG8_SCHED; PG8_LDA(At, 0, 0); PG8_STAGE(PG8_SA(1, 1), a1 + hstepA, voffA);
            PG8_WAIT_V(8); PG8_WAIT_L(0); PG8_BAR; PG8_MMA(0, 0, At, B0); PG8_MMA(0, 1, At, B1); PG8_BAR; PG8_SCHED;
            PG8_LDA(At, 0, 1); PG8_STAGE(PG8_SB(0, 0), b2, voffB); PG8_STAGE(PG8_SB(0, 1), b2 + hstepB, voffB); PG8_STAGE(PG8_SA(0, 0), a2, voffA);
            PG8_WAIT_V(8); PG8_WAIT_L(0); PG8_BAR; PG8_MMA(1, 0, At, B0); PG8_MMA(1, 1, At, B1); PG8_BAR; PG8_SCHED;
            PG8_LDB(B0, 1, 0); PG8_LDB(B1, 1, 1); PG8_SCHED; PG8_LDA(At, 1, 0); PG8_STAGE(PG8_SA(0, 1), a2 + hstepA, voffA);
            PG8_WAIT_V(8); PG8_WAIT_L(0); PG8_BAR; PG8_MMA(0, 0, At, B0); PG8_MMA(0, 1, At, B1); PG8_BAR; PG8_SCHED;
            PG8_LDA(At, 1, 1); PG8_STAGE(PG8_SB(1, 0), b3, voffB); PG8_STAGE(PG8_SB(1, 1), b3 + hstepB, voffB); PG8_STAGE(PG8_SA(1, 0), a3, voffA);
            PG8_WAIT_V(8); PG8_WAIT_L(0); PG8_BAR; PG8_MMA(1, 0, At, B0); PG8_MMA(1, 1, At, B1); PG8_BAR; PG8_SCHED;
            } else {
            PG8_LDB(B0, 0, 0); PG8_SCHED; PG8_LDA(At, 0, 0); PG8_STAGE(PG8_SA(1, 1), a1 + hstepA, voffA);
            PG8_WAIT_L(8); PG8_BAR; PG8_WAIT_L(0); PG8_MMA(0, 0, At, B0); PG8_BAR; PG8_SCHED;
            PG8_LDB(B1, 0, 1); PG8_STAGE(PG8_SB(0, 0), b2, voffB);
            PG8_BAR; PG8_WAIT_L(0); PG8_MMA(0, 1, At, B1); PG8_BAR;
            PG8_LDA(At, 0, 1); PG8_STAGE(PG8_SA(0, 0), a2, voffA);
            PG8_BAR; PG8_WAIT_L(0); PG8_MMA(1, 0, At, B0); PG8_BAR; PG8_SCHED;
            PG8_STAGE(PG8_SB(0, 1), b2 + hstepB, voffB);
            PG8_WAIT_V(6); PG8_BAR; PG8_MMA(1, 1, At, B1); PG8_BAR;
            PG8_LDB(B0, 1, 0); PG8_SCHED; PG8_LDA(At, 1, 0); PG8_STAGE(PG8_SA(0, 1), a2 + hstepA, voffA);
            PG8_WAIT_L(8); PG8_BAR; PG8_WAIT_L(0); PG8_MMA(0, 0, At, B0); PG8_BAR; PG8_SCHED;
            PG8_LDB(B1, 1, 1); PG8_STAGE(PG8_SB(1, 0), b3, voffB);
            PG8_BAR; PG8_WAIT_L(0); PG8_MMA(0, 1, At, B1); PG8_BAR;
            PG8_LDA(At, 1, 1); PG8_STAGE(PG8_SA(1, 0), a3, voffA);
            PG8_BAR; PG8_WAIT_L(0); PG8_MMA(1, 0, At, B0); PG8_BAR; PG8_SCHED;
            PG8_STAGE(PG8_SB(1, 1), b3 + hstepB, voffB);
            PG8_WAIT_V(6); PG8_BAR; PG8_MMA(1, 1, At, B1); PG8_BAR;
            }
        }
        if constexpr (ALIGN_EPI) { if (wr == 0) PG8_BAR; }
        if constexpr (!Epi::AFTER_DRAIN) { E(acc, cur, wr, wc, fr, fq); S.done(cur); }
        if constexpr (Epi::DEFER) { if (has_prv) E.deferred(prv); prv = cur; has_prv = true; }
        if (!has_next) break;
#pragma unroll
        for (int a = 0; a < 2; ++a)
#pragma unroll
            for (int b = 0; b < 2; ++b)
#pragma unroll
                for (int m = 0; m < 4; ++m)
#pragma unroll
                    for (int n = 0; n < 2; ++n) acc[a][b][m][n] = (f32x4){0.f, 0.f, 0.f, 0.f};
        cur = nxt; cA = nA; cB = nB; ++ui;
        if constexpr (ALIGN_EPI) { if (wr == 1) PG8_BAR; }
    }
    PG8_WAIT_V(0);
    if constexpr (!ALIGN_EPI) { if (wr == 0) PG8_BAR; }
    PG8_BAR;
    if constexpr (Epi::AFTER_DRAIN) { E.fused(acc, cur, wr, wc, fr, fq, lds, wid, lane); S.done(cur); }
    if constexpr (Epi::DEFER) { if (has_prv) E.deferred(prv); }
#undef PG8_SA
#undef PG8_SB
#undef PG8_STAGE
#undef PG8_LDA
#undef PG8_LDB
#undef PG8_MMA
#undef PG8_WAIT_V
#undef PG8_WAIT_L
#undef PG8_BAR
#undef PG8_SCHED
}
}

struct EpiStore {
    static constexpr bool PERM = true, AFTER_DRAIN = false, DEFER = false;
    bf16_t* O; int ldc;
    DI void operator()(const f32x4 (&acc)[2][2][4][2], const pg8::Unit& u, int wr, int wc, int fr, int fq) const {
        const int row0 = u.pm * 256 + wr * 64 + fr, col0 = u.pn * 256 + wc * 32 + 8 * fq;
#pragma unroll
        for (int ai = 0; ai < 2; ++ai)
#pragma unroll
            for (int m = 0; m < 4; ++m) { bf16_t* rowp = O + (size_t)(row0 + ai * 128 + m * 16) * ldc + col0;
#pragma unroll
                for (int bj = 0; bj < 2; ++bj) { const f32x4 v0 = acc[ai][bj][m][0], v1 = acc[ai][bj][m][1];
                    u32x4 w; w.x = pk2(v0[0], v0[1]); w.y = pk2(v0[2], v0[3]); w.z = pk2(v1[0], v1[1]); w.w = pk2(v1[2], v1[3]);
                    *(u32x4*)(rowp + bj * 128) = w; } }
    }
};
struct EpiProj {
    static constexpr bool PERM = true, AFTER_DRAIN = false, DEFER = false;
    bf16_t* proj; bf16_t* gates;
    DI void operator()(const f32x4 (&acc)[2][2][4][2], const pg8::Unit& u, int wr, int wc, int fr, int fq) const {
        const bool isg = u.pn >= NPROJ_TILES;
        bf16_t* base = isg ? gates : proj; const int ldc = isg ? 2048 : LDP; const int colt = isg ? (u.pn - NPROJ_TILES) * 256 : u.pn * 256;
        const int row0 = u.pm * 256 + wr * 64 + fr, col0 = colt + wc * 32 + 8 * fq;
#pragma unroll
        for (int ai = 0; ai < 2; ++ai)
#pragma unroll
            for (int m = 0; m < 4; ++m) { bf16_t* rowp = base + (size_t)(row0 + ai * 128 + m * 16) * ldc + col0;
#pragma unroll
                for (int bj = 0; bj < 2; ++bj) { f32x4 v0 = acc[ai][bj][m][0], v1 = acc[ai][bj][m][1];
                    if (isg) {
#pragma unroll
                        for (int j = 0; j < 4; ++j) { v0[j] = sigmoidf_(v0[j]); v1[j] = sigmoidf_(v1[j]); } }
                    u32x4 w; w.x = pk2(v0[0], v0[1]); w.y = pk2(v0[2], v0[3]); w.z = pk2(v1[0], v1[1]); w.w = pk2(v1[2], v1[3]);
                    *(u32x4*)(rowp + bj * 128) = w; } }
    }
};
struct EpiGate {
    static constexpr bool PERM = true, AFTER_DRAIN = false, DEFER = false;
    bf16_t* G; int second;
    DI void operator()(const f32x4 (&acc)[2][2][4][2], const pg8::Unit& u, int wr, int wc, int fr, int fq) const {
        const int row0 = u.pm * 256 + wr * 64 + fr, col0 = u.pn * 256 + wc * 32 + 8 * fq;
#pragma unroll
        for (int ai = 0; ai < 2; ++ai) {
            u32x4 gv[4][2], pv[4][2];
#pragma unroll
            for (int m = 0; m < 4; ++m) { const bf16_t* rowp = G + (size_t)(row0 + ai * 128 + m * 16) * 2048 + col0;
#pragma unroll
                for (int bj = 0; bj < 2; ++bj) { gv[m][bj] = *(const u32x4*)(rowp + bj * 128 + (second ? 1024 : 0)); if (second) pv[m][bj] = *(const u32x4*)(rowp + bj * 128); } }
            asm volatile("" ::: "memory");
#pragma unroll
            for (int m = 0; m < 4; ++m) { bf16_t* rowp = G + (size_t)(row0 + ai * 128 + m * 16) * 2048 + col0;
#pragma unroll
                for (int bj = 0; bj < 2; ++bj) { const f32x4 v0 = acc[ai][bj][m][0], v1 = acc[ai][bj][m][1];
                    const u32x4 g = gv[m][bj];
                    float r[8];
                    r[0] = bf_lo(g.x) * v0[0]; r[1] = bf_hi(g.x) * v0[1]; r[2] = bf_lo(g.y) * v0[2]; r[3] = bf_hi(g.y) * v0[3];
                    r[4] = bf_lo(g.z) * v1[0]; r[5] = bf_hi(g.z) * v1[1]; r[6] = bf_lo(g.w) * v1[2]; r[7] = bf_hi(g.w) * v1[3];
                    if (second) { const u32x4 p = pv[m][bj];
                        r[0] += bf_lo(p.x); r[1] += bf_hi(p.x); r[2] += bf_lo(p.y); r[3] += bf_hi(p.y); r[4] += bf_lo(p.z); r[5] += bf_hi(p.z); r[6] += bf_lo(p.w); r[7] += bf_hi(p.w); }
                    u32x4 w; w.x = pk2(r[0], r[1]); w.y = pk2(r[2], r[3]); w.z = pk2(r[4], r[5]); w.w = pk2(r[6], r[7]);
                    *(u32x4*)(rowp + bj * 128) = w; } }
            asm volatile("" ::: "memory");
        }
    }
};
struct EpiSwiglu {
    static constexpr bool PERM = true, AFTER_DRAIN = false, DEFER = false;
    bf16_t* O;
    DI void operator()(const f32x4 (&acc)[2][2][4][2], const pg8::Unit& u, int wr, int wc, int fr, int fq) const {
        const int row0 = u.pm * 256 + wr * 64 + fr, col0 = u.pn * 128 + wc * 32 + 8 * fq;
#pragma unroll
        for (int ai = 0; ai < 2; ++ai)
#pragma unroll
            for (int m = 0; m < 4; ++m) { bf16_t* rowp = O + (size_t)(row0 + ai * 128 + m * 16) * DFF + col0;
                float r[8];
#pragma unroll
                for (int n = 0; n < 2; ++n)
#pragma unroll
                    for (int j = 0; j < 4; ++j) { const float g = acc[ai][0][m][n][j], uu = acc[ai][1][m][n][j]; r[4 * n + j] = g * sigmoidf_(g) * uu; }
                u32x4 w; w.x = pk2(r[0], r[1]); w.y = pk2(r[2], r[3]); w.z = pk2(r[4], r[5]); w.w = pk2(r[6], r[7]);
                *(u32x4*)rowp = w; }
    }
};

namespace att {
using s16x4 = __attribute__((ext_vector_type(4))) short;
constexpr int D = 128, NW = 8, QBLK = 32, KVBLK = 64;
constexpr float SCALE = 0.088388347648318440f;
constexpr float THR = 8.f;
constexpr int SHM_V = KVBLK * D * 2, SHM_K = KVBLK * D * 2, SHM_ATTN = 2 * SHM_V + 2 * SHM_K + NW * 64 * 4;
#define KSWZ(row, colB) ((row) * 256 + ((colB) ^ (((row) & 7) << 4)))
#define SBAR() __builtin_amdgcn_sched_barrier(0)
DI unsigned cvtpk(float lo, float hi) { unsigned r; asm volatile("v_cvt_pk_bf16_f32 %0, %1, %2" : "=v"(r) : "v"(lo), "v"(hi)); return r; }
DI void partialSM(f32x16& p0, f32x16& p1, float& m_reg, float& mn, float& alpha) {
  constexpr float C = SCALE * 1.4426950408889634f;
  float pmax = p0[0]; for (int r = 1; r < 16; ++r) pmax = fmaxf(pmax, p0[r]); for (int r = 0; r < 16; ++r) pmax = fmaxf(pmax, p1[r]);
  { auto rr = __builtin_amdgcn_permlane32_swap(__float_as_uint(pmax), __float_as_uint(pmax), false, false);
    pmax = fmaxf(__uint_as_float(rr[0]), __uint_as_float(rr[1])); }
  if (__builtin_expect(__all(pmax - m_reg <= THR / SCALE), 1)) { mn = m_reg; alpha = 1.f; }
  else { mn = fmaxf(m_reg, pmax); alpha = __builtin_amdgcn_exp2f((m_reg - mn) * C); m_reg = mn; }
  float mnC = -mn * C;
  for (int r = 0; r < 16; ++r) p0[r] = fmaf(p0[r], C, mnC); for (int r = 0; r < 16; ++r) p1[r] = fmaf(p1[r], C, mnC);
  for (int r = 0; r < 16; ++r) p0[r] = __builtin_amdgcn_exp2f(p0[r]);
}
DI void finishSM(f32x16& p0, f32x16& p1, float alpha, float& l_reg, bf16x8& pa0, bf16x8& pa1, bf16x8& pa2, bf16x8& pa3) {
  for (int r = 0; r < 16; ++r) p1[r] = __builtin_amdgcn_exp2f(p1[r]);
  float ps = 0; for (int r = 0; r < 16; ++r) ps += p0[r]; for (int r = 0; r < 16; ++r) ps += p1[r];
  { auto rr = __builtin_amdgcn_permlane32_swap(__float_as_uint(ps), __float_as_uint(ps), false, false);
    ps = __uint_as_float(rr[0]) + __uint_as_float(rr[1]); }
  l_reg = l_reg * alpha + ps;
#define PK4(P, BASE, OUT) do { unsigned a0 = cvtpk(P[BASE + 0], P[BASE + 1]), a1 = cvtpk(P[BASE + 2], P[BASE + 3]);   \
    unsigned b0 = cvtpk(P[BASE + 4], P[BASE + 5]), b1 = cvtpk(P[BASE + 6], P[BASE + 7]);                              \
    auto r0 = __builtin_amdgcn_permlane32_swap(a0, b0, false, false); auto r1 = __builtin_amdgcn_permlane32_swap(a1, b1, false, false); \
    u32x4 w = {r0[0], r1[0], r0[1], r1[1]}; OUT = *reinterpret_cast<bf16x8*>(&w); } while (0)
  PK4(p0, 0, pa0); PK4(p0, 8, pa1); PK4(p1, 0, pa2); PK4(p1, 8, pa3);
#undef PK4
}
DI void qkt(f32x16& p0, f32x16& p1, const LAS char* Ks, const bf16x8* qr, int r32, int hi) {
  p0 = f32x16{}; p1 = f32x16{};
  for (int d0 = 0; d0 < 8; ++d0) { int cb = (d0 * 16 + hi * 8) * 2;
    bf16x8 b0 = *reinterpret_cast<const LAS bf16x8*>(Ks + KSWZ(r32, cb));
    bf16x8 b1 = *reinterpret_cast<const LAS bf16x8*>(Ks + KSWZ(32 + r32, cb));
    p0 = MFMA32(b0, qr[d0], p0);
    p1 = MFMA32(b1, qr[d0], p1); }
}
DI int v_st(int k, int c) { const int kk = (k & ~0xC) | ((k & 4) << 1) | ((k & 8) >> 1); return ((kk >> 3) * 4 + (c >> 5)) * 512 + ((kk & 7) * 32 + (c & 31)) * 2; }
DI int v_rd_base(int lane) { return ((lane & 3) << 3) | (((lane >> 2) & 3) << 6) | (((lane >> 4) & 1) << 5) | (((lane >> 5) & 1) << 8); }
constexpr int v_rd_off(int d0, int ks, int half) { return d0 * 512 + ks * 4096 + half * 2048; }
template <int OFF> DI s16x4 tr_read(int vb) {
  s16x4 r; asm volatile("ds_read_b64_tr_b16 %0, %1 offset:%2" : "=&v"(r) : "v"(vb), "i"(OFF) : "memory"); return r;
}
template <int D0> DI void pv_one(f32x16& od, int vb, bf16x8 pa0, bf16x8 pa1, bf16x8 pa2, bf16x8 pa3) {
  const s16x4 l0 = tr_read<v_rd_off(D0, 0, 0)>(vb), h0 = tr_read<v_rd_off(D0, 0, 1)>(vb), l1 = tr_read<v_rd_off(D0, 1, 0)>(vb), h1 = tr_read<v_rd_off(D0, 1, 1)>(vb);
  const s16x4 l2 = tr_read<v_rd_off(D0, 2, 0)>(vb), h2 = tr_read<v_rd_off(D0, 2, 1)>(vb), l3 = tr_read<v_rd_off(D0, 3, 0)>(vb), h3 = tr_read<v_rd_off(D0, 3, 1)>(vb);
  asm volatile("s_waitcnt lgkmcnt(0)" ::: "memory"); SBAR();
#define PK(L, H) (bf16x8){L[0], L[1], L[2], L[3], H[0], H[1], H[2], H[3]}
  od = MFMA32(pa0, PK(l0, h0), od);
  od = MFMA32(pa1, PK(l1, h1), od);
  od = MFMA32(pa2, PK(l2, h2), od);
  od = MFMA32(pa3, PK(l3, h3), od);
#undef PK
}
DI void pv_d0(f32x16* o, int vb, bf16x8 pa0, bf16x8 pa1, bf16x8 pa2, bf16x8 pa3) {
  pv_one<0>(o[0], vb, pa0, pa1, pa2, pa3); pv_one<1>(o[1], vb, pa0, pa1, pa2, pa3); pv_one<2>(o[2], vb, pa0, pa1, pa2, pa3); pv_one<3>(o[3], vb, pa0, pa1, pa2, pa3);
}
template <int LDQ, int LDK, int LDO>
DI void attn_dense_body(const bf16_t* __restrict__ Qb, const bf16_t* __restrict__ Kh, const bf16_t* __restrict__ Vh, bf16_t* __restrict__ Ob, int seq, LAS char* lds,
                        const float* __restrict__ qn, const float* __restrict__ tab, int tq0) {
  const int tid = tid_opaque(), wid = tid >> 6, lane = tid & 63, r32 = lane & 31, hi = lane >> 5;
  LAS char* V_lds = lds; LAS char* K_lds = lds + 2 * SHM_V;
  LAS float* ws = (LAS float*)(lds + 2 * SHM_V + 2 * SHM_K) + wid * 64; LAS float* li_l = ws; LAS float* al_l = ws + 32;
  float m_reg = -1e30f, l_reg = 0; f32x16 o[4] = {}; bf16x8 qr[8];
  const bf16_t* Qw = Qb + (long)(wid * QBLK + r32) * LDQ + hi * 8;
  {
    u32x4 raw[8];
#pragma unroll
    for (int d0 = 0; d0 < 8; ++d0) raw[d0] = *reinterpret_cast<const u32x4*>(Qw + d0 * 16);
    float ss = 0.f;
#pragma unroll
    for (int d0 = 0; d0 < 8; ++d0) { const float a0 = bf_lo(raw[d0].x), a1 = bf_hi(raw[d0].x), a2 = bf_lo(raw[d0].y), a3 = bf_hi(raw[d0].y), a4 = bf_lo(raw[d0].z), a5 = bf_hi(raw[d0].z), a6 = bf_lo(raw[d0].w), a7 = bf_hi(raw[d0].w);
      ss += ((a0 * a0 + a1 * a1) + (a2 * a2 + a3 * a3)) + ((a4 * a4 + a5 * a5) + (a6 * a6 + a7 * a7)); }
    ss += __shfl_xor(ss, 32);
    const float rstd = rsqrtf(ss * (1.f / 128.f) + 1e-6f);
    const int tq = tq0 + wid * QBLK + r32;
#pragma unroll
    for (int blk = 0; blk < 2; ++blk) {
      const int pos = blk ? (tq & 63) : (tq >> 6);
#pragma unroll
      for (int dd = 0; dd < 2; ++dd) {
        const int d0 = 4 * blk + dd, fb = dd * 16 + hi * 8;
        float x1[8], x2[8];
        x1[0] = bf_lo(raw[d0].x); x1[1] = bf_hi(raw[d0].x); x1[2] = bf_lo(raw[d0].y); x1[3] = bf_hi(raw[d0].y); x1[4] = bf_lo(raw[d0].z); x1[5] = bf_hi(raw[d0].z); x1[6] = bf_lo(raw[d0].w); x1[7] = bf_hi(raw[d0].w);
        x2[0] = bf_lo(raw[d0 + 2].x); x2[1] = bf_hi(raw[d0 + 2].x); x2[2] = bf_lo(raw[d0 + 2].y); x2[3] = bf_hi(raw[d0 + 2].y); x2[4] = bf_lo(raw[d0 + 2].z); x2[5] = bf_hi(raw[d0 + 2].z); x2[6] = bf_lo(raw[d0 + 2].w); x2[7] = bf_hi(raw[d0 + 2].w);
        float o1[8], o2[8];
#pragma unroll
        for (int hx = 0; hx < 2; ++hx) {
          const f32x4 g1 = *(const f32x4*)(qn + d0 * 16 + hi * 8 + 4 * hx), g2 = *(const f32x4*)(qn + (d0 + 2) * 16 + hi * 8 + 4 * hx);
          const f32x4 cs = *(const f32x4*)(tab + pos * 32 + fb + 4 * hx), sn = *(const f32x4*)(tab + 2048 + pos * 32 + fb + 4 * hx);
#pragma unroll
          for (int x = 0; x < 4; ++x) { const float a = x1[4 * hx + x] * rstd * g1[x], b = x2[4 * hx + x] * rstd * g2[x];
            o1[4 * hx + x] = a * cs[x] - b * sn[x]; o2[4 * hx + x] = b * cs[x] + a * sn[x]; }
        }
        u32x4 w1, w2;
        w1.x = pk2(o1[0], o1[1]); w1.y = pk2(o1[2], o1[3]); w1.z = pk2(o1[4], o1[5]); w1.w = pk2(o1[6], o1[7]);
        w2.x = pk2(o2[0], o2[1]); w2.y = pk2(o2[2], o2[3]); w2.z = pk2(o2[4], o2[5]); w2.w = pk2(o2[6], o2[7]);
        qr[d0] = __builtin_bit_cast(bf16x8, w1); qr[d0 + 2] = __builtin_bit_cast(bf16x8, w2);
      }
    }
  }
  const int sr = tid >> 4, sc = (tid & 15) * 8, vst0 = v_st(sr, sc), vst1 = v_st(32 + sr, sc);
  const int vb0 = (int)(uintptr_t)V_lds + v_rd_base(lane);
  struct { bf16x8 vs0, vs1, ks0, ks1; } sr_[2];
#define SLOAD(i, k0) do { sr_[i].vs0 = *reinterpret_cast<const bf16x8*>(&Vh[(long)((k0) + sr) * LDK + sc]); sr_[i].vs1 = *reinterpret_cast<const bf16x8*>(&Vh[(long)((k0) + 32 + sr) * LDK + sc]); \
    sr_[i].ks0 = *reinterpret_cast<const bf16x8*>(&Kh[(long)((k0) + sr) * LDK + sc]); sr_[i].ks1 = *reinterpret_cast<const bf16x8*>(&Kh[(long)((k0) + 32 + sr) * LDK + sc]); } while (0)
#define SWRITE(b, i) do { *(LAS bf16x8*)(V_lds + (b) * SHM_V + vst0) = sr_[i].vs0;          \
    *(LAS bf16x8*)(V_lds + (b) * SHM_V + vst1) = sr_[i].vs1; int kc = sc * 2;               \
    *(LAS bf16x8*)(K_lds + (b) * SHM_K + KSWZ(sr, kc)) = sr_[i].ks0;                       \
    *(LAS bf16x8*)(K_lds + (b) * SHM_K + KSWZ(32 + sr, kc)) = sr_[i].ks1; } while (0)
#define SWAIT() asm volatile("s_waitcnt vmcnt(4)" ::: "memory")
#define RESC(a) do { if (__any((a) < 1.f)) { if (hi == 0) al_l[r32] = (a); asm volatile("s_waitcnt lgkmcnt(0)" ::: "memory"); \
    for (int d = 0; d < 4; ++d) for (int r = 0; r < 16; ++r) o[d][r] *= al_l[crow(r, hi)]; } } while (0)
  f32x16 pA0, pA1, pB0, pB1; float mnA, mnB, alA, alB; bf16x8 pa0, pa1, pa2, pa3; const int NT = seq / KVBLK;
  constexpr int SE = 0, SO = 1;
  SLOAD(SE, 0); asm volatile("s_waitcnt vmcnt(0)" ::: "memory"); SWRITE(0, SE); __syncthreads();
  qkt(pA0, pA1, K_lds, qr, r32, hi); partialSM(pA0, pA1, m_reg, mnA, alA);
  SLOAD(SO, KVBLK); if (2 < NT) SLOAD(SE, 2 * KVBLK);
  SWAIT(); SWRITE(1, SO); __syncthreads();
  for (int j = 1; j + 1 < NT; j += 2) {
    SBAR(); qkt(pB0, pB1, K_lds + SHM_K, qr, r32, hi);
    finishSM(pA0, pA1, alA, l_reg, pa0, pa1, pa2, pa3); SBAR();
    SLOAD(SO, (j + 2) * KVBLK); SBAR();
    pv_d0(o, vb0, pa0, pa1, pa2, pa3); partialSM(pB0, pB1, m_reg, mnB, alB);
    __syncthreads(); SWAIT(); SWRITE(0, SE);
    RESC(alB); __syncthreads();
    SBAR(); qkt(pA0, pA1, K_lds, qr, r32, hi);
    finishSM(pB0, pB1, alB, l_reg, pa0, pa1, pa2, pa3); SBAR();
    if (j + 3 < NT) SLOAD(SE, (j + 3) * KVBLK); SBAR();
    pv_d0(o, vb0 + (int)SHM_V, pa0, pa1, pa2, pa3); partialSM(pA0, pA1, m_reg, mnA, alA);
    __syncthreads(); SWAIT(); SWRITE(1, SO);
    RESC(alA); __syncthreads();
  }
  SBAR(); qkt(pB0, pB1, K_lds + SHM_K, qr, r32, hi);
  finishSM(pA0, pA1, alA, l_reg, pa0, pa1, pa2, pa3); SBAR();
  pv_d0(o, vb0, pa0, pa1, pa2, pa3); partialSM(pB0, pB1, m_reg, mnB, alB);
  __syncthreads(); RESC(alB);
  finishSM(pB0, pB1, alB, l_reg, pa0, pa1, pa2, pa3); SBAR();
  pv_d0(o, vb0 + (int)SHM_V, pa0, pa1, pa2, pa3);
  if (hi == 0) li_l[r32] = l_reg; asm volatile("s_waitcnt lgkmcnt(0)" ::: "memory");
  float rli[16];
#pragma unroll
  for (int r = 0; r < 16; ++r) rli[r] = __builtin_amdgcn_rcpf(li_l[crow(r, hi)]);
  bf16_t* Ow = Ob + (long)(wid * QBLK) * LDO;
#pragma unroll
  for (int r = 0; r < 16; ++r) { int orow = crow(r, hi);
#pragma unroll
    for (int d0 = 0; d0 < 4; ++d0) Ow[(long)orow * LDO + d0 * 32 + r32] = f2bf(o[d0][r] * rli[r]); }
  __syncthreads();
#undef SLOAD
#undef SWRITE
#undef SWAIT
#undef RESC
}
}

namespace gla {
constexpr int QG_OFF = 0, KG_OFF = 17408, KGT_OFF = 34816, VT_OFF = 53248, PM_OFF = 90112, DEC_OFF = 99328, ZB_OFF = 99840, GB_OFF = 101888;
constexpr float QSCALE = 0.08838834764831845f;
DI void item(LAS char* lds, const bf16_t* __restrict__ proj, const bf16_t* __restrict__ gvt, bf16_t* __restrict__ ofb,
             const float* __restrict__ wa, const float* __restrict__ ba, int bl, int h, int dir) {
    const int tid = tid_opaque(), wid = tid >> 6, lane = tid & 63, r32 = lane & 31, hi = lane >> 5;
    const int d = tid & 127, part = tid >> 7;
    LAS char* QG = lds + QG_OFF; LAS char* KG = lds + KG_OFF; LAS char* KGT = lds + KGT_OFF; LAS char* VT = lds + VT_OFF; LAS char* PM = lds + PM_OFF;
    LAS float* DEC = (LAS float*)(lds + DEC_OFF); LAS char* ZB = lds + ZB_OFF; LAS char* GB = lds + GB_OFF;
    const int xib = wid & 1, xdb = wid >> 1;
    bf16x8 wfrag; float bav;
    { const float* wp = wa + (size_t)(8 * hi) * 512 + h * 128 + 32 * xdb + r32;
      u32x4 w; w.x = pk2(wp[0], wp[512]); w.y = pk2(wp[1024], wp[1536]); w.z = pk2(wp[2048], wp[2560]); w.w = pk2(wp[3072], wp[3584]);
      wfrag = __builtin_bit_cast(bf16x8, w); bav = ba[h * 128 + 32 * xdb + r32]; }
    f32x16 S[4];
#pragma unroll
    for (int i = 0; i < 4; ++i) S[i] = f32x16{};
    const int tb = bl * T;
    const int ew = 32 * wid;
    const int qrow = tid >> 4, qseg = tid & 15;
    const int zrow = (tid & 127) >> 1, zseg = tid & 1;
    const int ve = tid >> 3, vseg = tid & 7;
    u32x4 pq[2], pkk[2], pz, pv[4];
#define GLA_LOAD(cc) do { const int t0_ = tb + (cc) * 64; const bf16_t* cb_ = proj + (size_t)t0_ * LDP; \
        _Pragma("unroll") for (int x = 0; x < 2; ++x) { pq[x] = *(const u32x4*)(cb_ + (size_t)(qrow + 32 * x) * LDP + PC_GQ + h * 128 + qseg * 8); \
            pkk[x] = *(const u32x4*)(cb_ + (size_t)(qrow + 32 * x) * LDP + PC_GK + h * 128 + qseg * 8); } \
        pz = *(const u32x4*)(cb_ + (size_t)zrow * LDP + PC_Z + dir * 16 + zseg * 8); \
        _Pragma("unroll") for (int x = 0; x < 4; ++x) pv[x] = *(const u32x4*)(gvt + (size_t)(h * 256 + ve + 64 * x) * MR + t0_ + vseg * 8); } while (0)
    GLA_LOAD(dir ? 31 : 0);
    for (int n = 0; n < 32; ++n) {
        const int c = dir ? 31 - n : n; const int t0 = tb + c * 64;
        __syncthreads();
#pragma unroll
        for (int x = 0; x < 2; ++x) { *(LAS u32x4*)(QG + (qrow + 32 * x) * 272 + qseg * 16) = pq[x]; *(LAS u32x4*)(KG + (qrow + 32 * x) * 272 + qseg * 16) = pkk[x]; }
        if (tid < 128) *(LAS u32x4*)(ZB + zrow * 32 + zseg * 16) = pz;
#pragma unroll
        for (int x = 0; x < 4; ++x) *(LAS u32x4*)(VT + (ve + 64 * x) * 144 + vseg * 16) = pv[x];
        if (n + 1 < 32) GLA_LOAD(dir ? 30 - n : n + 1);
        __syncthreads();
        {
            const bf16x8 za = *(const LAS bf16x8*)(ZB + (32 * xib + r32) * 32 + hi * 16);
            const f32x16 xa = MFMA32(za, wfrag, f32x16{});
#pragma unroll
            for (int g = 0; g < 4; ++g) { f32x4 gv;
#pragma unroll
                for (int x = 0; x < 4; ++x) { const float xv = xa[4 * g + x] + bav; gv[x] = (fminf(xv, 0.f) - __logf(1.f + __expf(-fabsf(xv)))) * (1.f / 16.f); }
                *(LAS f32x4*)(GB + (32 * xdb + r32) * 272 + (32 * xib + 8 * g + 4 * hi) * 4) = gv; }
        }
        __syncthreads();
        int d = tid & 127, part = tid >> 7; asm volatile("" : "+v"(d), "+v"(part));
        float bc[16]; float tot;
        {
            float ps[4];
#pragma unroll
            for (int p = 0; p < 4; ++p) { float a = 0.f;
#pragma unroll
                for (int q = 0; q < 4; ++q) { const f32x4 v = *(const LAS f32x4*)(GB + d * 272 + p * 64 + q * 16); a += (v[0] + v[1]) + (v[2] + v[3]);
                    if (p == part) { bc[4 * q] = v[0]; bc[4 * q + 1] = v[1]; bc[4 * q + 2] = v[2]; bc[4 * q + 3] = v[3]; } }
                ps[p] = a; }
            tot = (ps[0] + ps[1]) + (ps[2] + ps[3]);
            float off;
            if (dir == 0) off = (part > 0 ? ps[0] : 0.f) + (part > 1 ? ps[1] : 0.f) + (part > 2 ? ps[2] : 0.f);
            else off = (part < 3 ? ps[3] : 0.f) + (part < 2 ? ps[2] : 0.f) + (part < 1 ? ps[1] : 0.f);
            if (dir == 0) { bc[0] += off;
#pragma unroll
                for (int rr = 1; rr < 16; ++rr) bc[rr] += bc[rr - 1];
            } else { bc[15] += off;
#pragma unroll
                for (int rr = 14; rr >= 0; --rr) bc[rr] += bc[rr + 1];
            }
        }
        if (part == 0) DEC[d] = __expf(tot);
        unsigned kpk[8];
#pragma unroll
        for (int rr = 0; rr < 16; rr += 2) {
            float kv2[2];
#pragma unroll
            for (int x = 0; x < 2; ++x) {
                const int i = part * 16 + rr + x;
                LAS bf16_t* qp = (LAS bf16_t*)(QG + i * 272 + d * 2); LAS bf16_t* kp = (LAS bf16_t*)(KG + i * 272 + d * 2);
                const float eb = __expf(bc[rr + x]);
                const float qv = bf2f(*qp) * QSCALE * eb;
                const float kv = bf2f(*kp) * __builtin_amdgcn_rcpf(eb);
                *qp = f2bf(qv); *kp = f2bf(kv);
                kv2[x] = kv;
            }
            kpk[rr >> 1] = pk2(kv2[0], kv2[1]);
        }
        {
            u32x4 w0, w1;
            w0.x = kpk[0]; w0.y = kpk[1]; w0.z = kpk[2]; w0.w = kpk[3]; w1.x = kpk[4]; w1.y = kpk[5]; w1.z = kpk[6]; w1.w = kpk[7];
            *(LAS u32x4*)(KGT + d * 144 + part * 32) = w0; *(LAS u32x4*)(KGT + d * 144 + part * 32 + 16) = w1;
        }
        __syncthreads();
        if (wid < 4) {
            int r32 = lane & 31, hi = lane >> 5; asm volatile("" : "+v"(r32), "+v"(hi));
            const int jb = wid >> 1, ib = wid & 1;
            f32x16 acc = f32x16{};
#pragma unroll
            for (int s = 0; s < 8; ++s) {
                const bf16x8 a = *(const LAS bf16x8*)(KG + (32 * jb + r32) * 272 + (16 * s + 8 * hi) * 2);
                const bf16x8 b = *(const LAS bf16x8*)(QG + (32 * ib + r32) * 272 + (16 * s + 8 * hi) * 2);
                acc = MFMA32(a, b, acc);
            }
            int i = 32 * ib + r32; asm volatile("" : "+v"(i));
#pragma unroll
            for (int g = 0; g < 4; ++g) { const int jbase = 32 * jb + 8 * g + 4 * hi; float v[4];
#pragma unroll
                for (int x = 0; x < 4; ++x) { const int j = jbase + x; const bool keep = dir ? (j > i) : (j <= i); v[x] = keep ? acc[4 * g + x] : 0.f; }
                u32x2 w; w.x = pk2(v[0], v[1]); w.y = pk2(v[2], v[3]);
                *(LAS u32x2*)(PM + i * 144 + jbase * 2) = w; }
        }
        __syncthreads();
        int r32 = lane & 31, hi = lane >> 5; asm volatile("" : "+v"(r32), "+v"(hi));
        f32x16 o[2]; o[0] = f32x16{}; o[1] = f32x16{};
#pragma unroll
        for (int db = 0; db < 4; ++db)
#pragma unroll
            for (int s = 0; s < 2; ++s) {
                u32x4 bw; bw.x = pk2(S[db][8 * s + 0], S[db][8 * s + 1]); bw.y = pk2(S[db][8 * s + 2], S[db][8 * s + 3]);
                bw.z = pk2(S[db][8 * s + 4], S[db][8 * s + 5]); bw.w = pk2(S[db][8 * s + 6], S[db][8 * s + 7]);
                const bf16x8 bfrag = __builtin_bit_cast(bf16x8, bw);
                const int d0 = 32 * db + 16 * s + 4 * hi;
#pragma unroll
                for (int ib = 0; ib < 2; ++ib) {
                    const u32x2 a0 = *(const LAS u32x2*)(QG + (32 * ib + r32) * 272 + d0 * 2), a1 = *(const LAS u32x2*)(QG + (32 * ib + r32) * 272 + (d0 + 8) * 2);
                    u32x4 aw; aw.x = a0.x; aw.y = a0.y; aw.z = a1.x; aw.w = a1.y;
                    o[ib] = MFMA32(__builtin_bit_cast(bf16x8, aw), bfrag, o[ib]);
                }
            }
        bf16x8 vb[4];
#pragma unroll
        for (int s = 0; s < 4; ++s) vb[s] = *(const LAS bf16x8*)(VT + (ew + r32) * 144 + (16 * s + 8 * hi) * 2);
#pragma unroll
        for (int s = 0; s < 4; ++s)
#pragma unroll
            for (int ib = 0; ib < 2; ++ib) { const bf16x8 a = *(const LAS bf16x8*)(PM + (32 * ib + r32) * 144 + (16 * s + 8 * hi) * 2); o[ib] = MFMA32(a, vb[s], o[ib]); }
        {
            LAS char* OS = lds + GB_OFF + wid * 5120;
#pragma unroll
            for (int ib = 0; ib < 2; ++ib)
#pragma unroll
                for (int r = 0; r < 16; ++r) *(LAS bf16_t*)(OS + (32 * ib + crow(r, hi)) * 80 + r32 * 2) = f2bf(o[ib][r]);
            asm volatile("s_waitcnt lgkmcnt(0)" ::: "memory");
#pragma unroll
            for (int x = 0; x < 4; ++x) { const int p = lane + 64 * x, row = p >> 2, seg = p & 3;
                const u32x4 v = *(const LAS u32x4*)(OS + row * 80 + seg * 16);
                *(u32x4*)(ofb + (size_t)(t0 + row) * 1024 + h * 256 + ew + seg * 8) = v; }
        }
#pragma unroll
        for (int db = 0; db < 4; ++db) {
#pragma unroll
            for (int s = 0; s < 4; ++s) { const bf16x8 a = *(const LAS bf16x8*)(KGT + (32 * db + r32) * 144 + (16 * s + 8 * hi) * 2); S[db] = MFMA32(a, vb[s], S[db]); }
#pragma unroll
            for (int g = 0; g < 4; ++g) { const f32x4 dc = *(const LAS f32x4*)(DEC + 32 * db + 8 * g + 4 * hi);
#pragma unroll
                for (int x = 0; x < 4; ++x) S[db][4 * g + x] *= dc[x]; }
        }
    }
    __syncthreads();
#undef GLA_LOAD
}
}

namespace xat {
constexpr int KS_OFF = 0, KS_STRIDE = 528, VS_OFF = 34816, VS_STRIDE = 144, L_OFF = 34816 + 36864;
DI void unit(LAS char* lds, const bf16_t* __restrict__ qx, const bf16_t* __restrict__ kmem, const bf16_t* __restrict__ vtmem, bf16_t* __restrict__ ox, int b, int hx, int qb) {
    const int tid = tid_opaque(), wid = tid >> 6, lane = tid & 63, r32 = lane & 31, hi = lane >> 5;
    LAS char* KS = lds + KS_OFF; LAS char* VS = lds + VS_OFF; LAS float* LL = (LAS float*)(lds + L_OFF) + wid * 32;
    const int m0 = b * T + qb * 256 + wid * 32;
    bf16x8 qf[16];
    { const bf16_t* qp = qx + (size_t)(m0 + r32) * 1024 + hx * 256 + hi * 8;
#pragma unroll
      for (int s = 0; s < 16; ++s) qf[s] = *(const bf16x8*)(qp + 16 * s); }
    f32x16 sc[8];
#pragma unroll
    for (int kt = 0; kt < 4; ++kt) {
#pragma unroll
        for (int x = 0; x < 4; ++x) { const int p = tid + 512 * x, key = p >> 5, seg = p & 31;
            const u32x4 v = *(const u32x4*)(kmem + (size_t)(b * NMEM + 64 * kt + key) * 1024 + hx * 256 + seg * 8);
            *(LAS u32x4*)(KS + key * KS_STRIDE + seg * 16) = v; }
        __syncthreads();
#pragma unroll
        for (int kb = 0; kb < 2; ++kb) { f32x16 acc = f32x16{};
#pragma unroll
            for (int s = 0; s < 16; ++s) { const bf16x8 a = *(const LAS bf16x8*)(KS + (32 * kb + r32) * KS_STRIDE + (16 * s + 8 * hi) * 2); acc = MFMA32(a, qf[s], acc); }
            sc[kt * 2 + kb] = acc; }
        __syncthreads();
    }
    float mx = sc[0][0];
#pragma unroll
    for (int t = 0; t < 8; ++t)
#pragma unroll
        for (int r = 0; r < 16; ++r) mx = fmaxf(mx, sc[t][r]);
    mx = fmaxf(mx, __shfl_xor(mx, 32));
    float sum = 0.f;
    u32x4 pp[8][2];
#pragma unroll
    for (int t = 0; t < 8; ++t) {
#pragma unroll
        for (int r = 0; r < 16; ++r) { const float e = __expf(sc[t][r] - mx); sum += e; sc[t][r] = e; }
#pragma unroll
        for (int s = 0; s < 2; ++s) { pp[t][s].x = pk2(sc[t][8 * s + 0], sc[t][8 * s + 1]); pp[t][s].y = pk2(sc[t][8 * s + 2], sc[t][8 * s + 3]);
            pp[t][s].z = pk2(sc[t][8 * s + 4], sc[t][8 * s + 5]); pp[t][s].w = pk2(sc[t][8 * s + 6], sc[t][8 * s + 7]); }
    }
    sum += __shfl_xor(sum, 32);
    if (hi == 0) LL[r32] = sum;
    f32x16 o[8];
#pragma unroll
    for (int eb = 0; eb < 8; ++eb) o[eb] = f32x16{};
#pragma unroll
    for (int kt = 0; kt < 4; ++kt) {
#pragma unroll
        for (int x = 0; x < 4; ++x) { const int p = tid + 512 * x, e = p >> 3, seg = p & 7;
            const u32x4 v = *(const u32x4*)(vtmem + (size_t)(hx * 256 + e) * MMEM + b * NMEM + 64 * kt + seg * 8);
            *(LAS u32x4*)(VS + e * VS_STRIDE + seg * 16) = v; }
        __syncthreads();
#pragma unroll
        for (int kb = 0; kb < 2; ++kb)
#pragma unroll
            for (int s = 0; s < 2; ++s) { const bf16x8 a = __builtin_bit_cast(bf16x8, pp[kt * 2 + kb][s]); const int k0 = 32 * kb + 16 * s + 4 * hi;
#pragma unroll
                for (int eb = 0; eb < 8; ++eb) {
                    const u32x2 b0 = *(const LAS u32x2*)(VS + (32 * eb + r32) * VS_STRIDE + k0 * 2), b1 = *(const LAS u32x2*)(VS + (32 * eb + r32) * VS_STRIDE + (k0 + 8) * 2);
                    u32x4 bw; bw.x = b0.x; bw.y = b0.y; bw.z = b1.x; bw.w = b1.y;
                    o[eb] = MFMA32(a, __builtin_bit_cast(bf16x8, bw), o[eb]); } }
        __syncthreads();
    }
    float rl[16];
#pragma unroll
    for (int r = 0; r < 16; ++r) rl[r] = __builtin_amdgcn_rcpf(LL[crow(r, hi)]);
#pragma unroll
    for (int r = 0; r < 16; ++r) { bf16_t* op = ox + (size_t)(m0 + crow(r, hi)) * 1024 + hx * 256 + r32;
#pragma unroll
        for (int eb = 0; eb < 8; ++eb) op[32 * eb] = f2bf(o[eb][r] * rl[r]); }
}
}

struct Args { const float* in[27]; float* out; unsigned char* ws; int ph_lo, ph_hi; };
enum { I_XP = 0, I_XS, I_MP, I_MS, I_LN_MIX_PRE, I_W_IN, I_WA_F, I_BA_F, I_WA_B, I_BA_B, I_GLA_NORM, I_QNORM, I_KNORM, I_W_BR_GLA, I_W_BR_ATT, I_W_OUT, I_LN_MIX_POST,
       I_LN_X_PRE, I_LN_MEM, I_X_WQ, I_X_WKV, I_X_WO, I_LN_X_POST, I_LN_FFN_PRE, I_FFN_WI, I_FFN_WO, I_LN_FFN_POST };

DI void transpose_seg(const float* __restrict__ W, int K, int ldw, int c0, int ncols, bf16_t* __restrict__ WT, int drow0, int mode, float sc, LAS float* scr, int gw, int NGW, int lane) {
    const int nblk = ncols / 32, nitems = (K / 64) * nblk;
    for (int it = gw; it < nitems; it += NGW) {
        const int kb = it / nblk, nb = it % nblk, k0 = 64 * kb, n0 = 32 * nb;
#pragma unroll 8
        for (int i = 0; i < 32; ++i) { const int kk = 2 * i + (lane >> 5); scr[kk * 33 + (lane & 31)] = W[(size_t)(k0 + kk) * ldw + c0 + n0 + (lane & 31)]; }
        asm volatile("s_waitcnt lgkmcnt(0)" ::: "memory");
        const int c = lane & 7;
#pragma unroll
        for (int j = 0; j < 4; ++j) { const int n = (lane >> 3) + 8 * j; const LAS float* s = scr + (8 * c) * 33 + n;
            u32x4 o; o.x = pk2(s[0 * 33] * sc, s[1 * 33] * sc); o.y = pk2(s[2 * 33] * sc, s[3 * 33] * sc); o.z = pk2(s[4 * 33] * sc, s[5 * 33] * sc); o.w = pk2(s[6 * 33] * sc, s[7 * 33] * sc);
            const int cs = n0 + n;
            int drow;
            if (mode == 1) { const int cc = c0 + cs; drow = cc < DFF ? (cc / 128) * 256 + (cc % 128) : ((cc - DFF) / 128) * 256 + 128 + ((cc - DFF) % 128); }
            else drow = drow0 + cs;
            *(u32x4*)(WT + (size_t)drow * K + k0 + 8 * c) = o; }
        asm volatile("s_waitcnt lgkmcnt(0)" ::: "memory");
    }
}
DI void rms_row_to_bf16(const float* __restrict__ xrow, const float* __restrict__ w, bf16_t* __restrict__ orow, int lane) {
    const f32x4* xr = (const f32x4*)xrow + lane; const f32x4* wr = (const f32x4*)w + lane;
    f32x4 v[4]; float s = 0.f;
#pragma unroll
    for (int j = 0; j < 4; ++j) { v[j] = xr[64 * j]; s += (v[j].x * v[j].x + v[j].y * v[j].y) + (v[j].z * v[j].z + v[j].w * v[j].w); }
    const float rstd = rsqrtf(wave_sum(s) * (1.f / 1024.f) + EPS);
    u32x2* o8 = (u32x2*)orow + lane;
#pragma unroll
    for (int j = 0; j < 4; ++j) { const f32x4 g = wr[64 * j]; u32x2 p; p.x = pk2(v[j].x * rstd * g.x, v[j].y * rstd * g.y); p.y = pk2(v[j].z * rstd * g.z, v[j].w * rstd * g.w); o8[64 * j] = p; }
}
DI void norm_res_row(const bf16_t* __restrict__ yrow, const float* __restrict__ base, const float* __restrict__ wpost, float* __restrict__ outrow,
                     const float* __restrict__ wpre, bf16_t* __restrict__ hrow, int lane) {
    const u32x2* yr = (const u32x2*)yrow + lane;
    f32x4 y[4]; float s = 0.f;
#pragma unroll
    for (int j = 0; j < 4; ++j) { const u32x2 p = yr[64 * j]; y[j].x = bf_lo(p.x); y[j].y = bf_hi(p.x); y[j].z = bf_lo(p.y); y[j].w = bf_hi(p.y);
        s += (y[j].x * y[j].x + y[j].y * y[j].y) + (y[j].z * y[j].z + y[j].w * y[j].w); }
    const float rstd = rsqrtf(wave_sum(s) * (1.f / 1024.f) + EPS);
    float s2 = 0.f;
#pragma unroll
    for (int j = 0; j < 4; ++j) { const f32x4 b = ((const f32x4*)base)[lane + 64 * j], g = ((const f32x4*)wpost)[lane + 64 * j];
        y[j] = b + y[j] * rstd * g; ((f32x4*)outrow)[lane + 64 * j] = y[j];
        s2 += (y[j].x * y[j].x + y[j].y * y[j].y) + (y[j].z * y[j].z + y[j].w * y[j].w); }
    if (hrow) {
        const float rstd2 = rsqrtf(wave_sum(s2) * (1.f / 1024.f) + EPS);
#pragma unroll
        for (int j = 0; j < 4; ++j) { const f32x4 g = ((const f32x4*)wpre)[lane + 64 * j]; u32x2 p; p.x = pk2(y[j].x * rstd2 * g.x, y[j].y * rstd2 * g.y); p.y = pk2(y[j].z * rstd2 * g.z, y[j].w * rstd2 * g.w);
            ((u32x2*)hrow)[lane + 64 * j] = p; }
    }
}

#ifndef EN_GLA
#define EN_GLA 1
#endif
#ifndef EN_ATT
#define EN_ATT 1
#endif
#ifndef EN_XAT
#define EN_XAT 1
#endif
#ifndef EN_GEMM
#define EN_GEMM 1
#endif
#ifndef REP_INPROJ
#define REP_INPROJ(r) 1
#endif
#ifndef REP_N1024
#define REP_N1024 1
#endif
constexpr int NPHASE = 14;
struct Ctx {
    LAS unsigned char* lds; int wave, G, bx, gw, NGW;
    const float* const* in; float* out; unsigned char* ws;
};
#define WSP(off) ((bf16_t*)(c.ws + (off)))
#define XROW(m) ((m) < 16 * T ? c.in[I_XP] + (size_t)(m) * 1024 : c.in[I_XS] + (size_t)((m) - 16 * T) * 1024)
#define GEMM(EPI, e, Ap, lda_, Bp, ldb_, M_, N_, K_) do { pg8::Gemm g_{Ap, Bp, M_, N_, K_, lda_, ldb_}; pg8::StaticOrder S_; S_.init(M_, N_, c.G, c.bx); S_.rep = gemm_rep; \
        if (EN_GEMM) pg8::gemm_phase<EPI, pg8::StaticOrder, true, true>(c.lds, g_, S_, e); } while (0)

DI void rms_rows_to_bf16(const Ctx& c, int row0, int nrows, const float* __restrict__ w, bf16_t* __restrict__ dst, int lane, int wv, int nwv) {
    constexpr int NR = 4;
    for (int m0 = wv * NR; m0 < nrows; m0 += nwv * NR) {
        f32x4 v[NR][4]; float s[NR];
#pragma unroll
        for (int k = 0; k < NR; ++k) { const float* xr = XROW(row0 + m0 + k);
#pragma unroll
            for (int j = 0; j < 4; ++j) v[k][j] = ((const f32x4*)xr)[lane + 64 * j]; }
#pragma unroll
        for (int k = 0; k < NR; ++k) { s[k] = 0.f;
#pragma unroll
            for (int j = 0; j < 4; ++j) s[k] += (v[k][j].x * v[k][j].x + v[k][j].y * v[k][j].y) + (v[k][j].z * v[k][j].z + v[k][j].w * v[k][j].w); }
#pragma unroll
        for (int off = 1; off < 64; off <<= 1)
#pragma unroll
            for (int k = 0; k < NR; ++k) s[k] += __shfl_xor(s[k], off);
#pragma unroll
        for (int k = 0; k < NR; ++k) { const float rstd = rsqrtf(s[k] * (1.f / 1024.f) + EPS);
#pragma unroll
            for (int j = 0; j < 4; ++j) { const f32x4 g = ((const f32x4*)w)[lane + 64 * j]; u32x2 p; p.x = pk2(v[k][j].x * rstd * g.x, v[k][j].y * rstd * g.y); p.y = pk2(v[k][j].z * rstd * g.z, v[k][j].w * rstd * g.w);
                ((u32x2*)(dst + (size_t)(m0 + k) * 1024))[lane + 64 * j] = p; } }
    }
}
struct NormP { const bf16_t* Yb; const float* xp; const float* xs; float* out; const float* wpost; const float* wpre; bf16_t* Hb; int first; const bf16_t* Xin; bf16_t* Xout; };
DI void norm_rows(const NormP& P, int row0, int nrows, int wv, int nwv, int lane) {
    constexpr int NR = 4;
    for (int i0 = wv * NR; i0 < nrows; i0 += nwv * NR) {
        const int m0 = row0 + i0;
        u32x2 yp[NR][4]; f32x4 bs[NR][4];
#pragma unroll
        for (int k = 0; k < NR; ++k) { const int m = m0 + k; const float* base = P.first ? (m < 16 * T ? P.xp + (size_t)m * 1024 : P.xs + (size_t)(m - 16 * T) * 1024) : P.out + (size_t)m * 1024;
#pragma unroll
            for (int j = 0; j < 4; ++j) { yp[k][j] = ((const u32x2*)(P.Yb + (size_t)m * 1024))[lane + 64 * j]; bs[k][j] = ((const f32x4*)base)[lane + 64 * j]; } }
        float s[NR];
#pragma unroll
        for (int k = 0; k < NR; ++k) { s[k] = 0.f;
#pragma unroll
            for (int j = 0; j < 4; ++j) { const float a0 = bf_lo(yp[k][j].x), a1 = bf_hi(yp[k][j].x), a2 = bf_lo(yp[k][j].y), a3 = bf_hi(yp[k][j].y); s[k] += (a0 * a0 + a1 * a1) + (a2 * a2 + a3 * a3); } }
#pragma unroll
        for (int off = 1; off < 64; off <<= 1)
#pragma unroll
            for (int k = 0; k < NR; ++k) s[k] += __shfl_xor(s[k], off);
        float s2[NR];
#pragma unroll
        for (int k = 0; k < NR; ++k) { const int m = m0 + k; const float rstd = rsqrtf(s[k] * (1.f / 1024.f) + EPS); s2[k] = 0.f;
#pragma unroll
            for (int j = 0; j < 4; ++j) { const f32x4 g = ((const f32x4*)P.wpost)[lane + 64 * j];
                f32x4 y; y.x = bf_lo(yp[k][j].x); y.y = bf_hi(yp[k][j].x); y.z = bf_lo(yp[k][j].y); y.w = bf_hi(yp[k][j].y);
                bs[k][j] = bs[k][j] + y * rstd * g; ((f32x4*)(P.out + (size_t)m * 1024))[lane + 64 * j] = bs[k][j];
                s2[k] += (bs[k][j].x * bs[k][j].x + bs[k][j].y * bs[k][j].y) + (bs[k][j].z * bs[k][j].z + bs[k][j].w * bs[k][j].w); } }
        if (P.Hb) {
#pragma unroll
            for (int off = 1; off < 64; off <<= 1)
#pragma unroll
                for (int k = 0; k < NR; ++k) s2[k] += __shfl_xor(s2[k], off);
#pragma unroll
            for (int k = 0; k < NR; ++k) { const int m = m0 + k; const float rstd2 = rsqrtf(s2[k] * (1.f / 1024.f) + EPS);
#pragma unroll
                for (int j = 0; j < 4; ++j) { const f32x4 g = ((const f32x4*)P.wpre)[lane + 64 * j]; u32x2 p; p.x = pk2(bs[k][j].x * rstd2 * g.x, bs[k][j].y * rstd2 * g.y); p.y = pk2(bs[k][j].z * rstd2 * g.z, bs[k][j].w * rstd2 * g.w);
                    ((u32x2*)(P.Hb + (size_t)m * 1024))[lane + 64 * j] = p; } }
        }
    }
}
template <int MODE>
struct EpiStoreNorm {
    static constexpr bool FIRST = MODE == 0, XOUT = MODE != 2, HOUT = MODE != 2;
    static constexpr bool PERM = true, AFTER_DRAIN = false, DEFER = true;
    bf16_t* O; unsigned* cnt; NormP P;
    DI void operator()(const f32x4 (&acc)[2][2][4][2], const pg8::Unit& u, int wr, int wc, int fr, int fq) const {
        const __amdgpu_buffer_rsrc_t rs = __builtin_amdgcn_make_buffer_rsrc(O, 0, MTOT * 1024 * 2, 0x00020000);
        const int row0 = u.pm * 256 + wr * 64 + fr, col0 = u.pn * 256 + wc * 32 + 8 * fq;
#pragma unroll
        for (int ai = 0; ai < 2; ++ai)
#pragma unroll
            for (int m = 0; m < 4; ++m) { const unsigned off = (unsigned)(((row0 + ai * 128 + m * 16) * 1024 + col0) * 2);
#pragma unroll
                for (int bj = 0; bj < 2; ++bj) { const f32x4 v0 = acc[ai][bj][m][0], v1 = acc[ai][bj][m][1];
                    u32x4 w; w.x = pk2(v0[0], v0[1]); w.y = pk2(v0[2], v0[3]); w.z = pk2(v1[0], v1[1]); w.w = pk2(v1[2], v1[3]);
                    __builtin_amdgcn_raw_buffer_store_b128(w, rs, off + bj * 256, 0, 16); } }
        asm volatile("s_waitcnt vmcnt(0)" ::: "memory");
        __builtin_amdgcn_s_barrier();
        if (threadIdx.x == 0) __hip_atomic_fetch_add(cnt + 16 * u.pm, 1u, __ATOMIC_RELAXED, __HIP_MEMORY_SCOPE_AGENT);
        if (!stagger()) normpass(u);
    }
    DI bool stagger() const { return ((blockIdx.x >> 3) & 1) != 0; }
    DI void deferred(const pg8::Unit& u) const { if (stagger()) normpass(u); }
    DI void normpass(const pg8::Unit& u) const {
        const int tid = threadIdx.x, lane = tid & 63;
        const int mrow = u.pm * 256 + u.pn * 64 + (tid >> 6) * 8;
        constexpr int NR = 4;
        f32x4 bs[NR][4];
#define NE_LOAD(m, dst) do { if constexpr (FIRST) { const float* b_ = (m) < 16 * T ? P.xp + (size_t)(m) * 1024 : P.xs + (size_t)((m) - 16 * T) * 1024; \
            _Pragma("unroll") for (int j = 0; j < 4; ++j) dst[j] = ((const f32x4*)b_)[lane + 64 * j]; } \
        else { _Pragma("unroll") for (int j = 0; j < 4; ++j) { const u32x2 p_ = ((const u32x2*)(P.Xin + (size_t)(m) * 1024))[lane + 64 * j]; \
            dst[j].x = bf_lo(p_.x); dst[j].y = bf_hi(p_.x); dst[j].z = bf_lo(p_.y); dst[j].w = bf_hi(p_.y); } } } while (0)
#pragma unroll
        for (int k = 0; k < NR; ++k) NE_LOAD(mrow + k, bs[k]);
        f32x4 gpost[4];
#pragma unroll
        for (int j = 0; j < 4; ++j) gpost[j] = ((const f32x4*)P.wpost)[lane + 64 * j];
        asm volatile("s_waitcnt vmcnt(0)" ::: "memory");
        if (tid == 0) { unsigned* cw = cnt + 16 * u.pm;
            unsigned sp = 0;
            while (__hip_atomic_load(cw, __ATOMIC_RELAXED, __HIP_MEMORY_SCOPE_AGENT) < 4u) { __builtin_amdgcn_s_sleep(1); if (++sp > (1u << 22)) break; }
            __builtin_amdgcn_fence(__ATOMIC_ACQUIRE, "agent"); asm volatile("s_waitcnt vmcnt(0)" ::: "memory"); }
        __builtin_amdgcn_s_barrier();
        asm volatile("" ::: "memory");
#pragma unroll
        for (int pass = 0; pass < 2; ++pass) {
            const int mr = mrow + 4 * pass;
            if (pass == 1) {
#pragma unroll
                for (int k = 0; k < NR; ++k) NE_LOAD(mr + k, bs[k]);
            }
            u32x2 yp[NR][4];
#pragma unroll
            for (int k = 0; k < NR; ++k)
#pragma unroll
                for (int j = 0; j < 4; ++j) yp[k][j] = ((const u32x2*)(P.Yb + (size_t)(mr + k) * 1024))[lane + 64 * j];
            float s1[NR];
#pragma unroll
            for (int k = 0; k < NR; ++k) { s1[k] = 0.f;
#pragma unroll
                for (int j = 0; j < 4; ++j) { const float a0 = bf_lo(yp[k][j].x), a1 = bf_hi(yp[k][j].x), a2 = bf_lo(yp[k][j].y), a3 = bf_hi(yp[k][j].y); s1[k] += (a0 * a0 + a1 * a1) + (a2 * a2 + a3 * a3); } }
#pragma unroll
            for (int off = 1; off < 64; off <<= 1)
#pragma unroll
                for (int k = 0; k < NR; ++k) s1[k] += __shfl_xor(s1[k], off);
            float s2[NR];
#pragma unroll
            for (int k = 0; k < NR; ++k) { const int m = mr + k; const float rstd = rsqrtf(s1[k] * (1.f / 1024.f) + EPS); s2[k] = 0.f;
#pragma unroll
                for (int j = 0; j < 4; ++j) { f32x4 y; y.x = bf_lo(yp[k][j].x); y.y = bf_hi(yp[k][j].x); y.z = bf_lo(yp[k][j].y); y.w = bf_hi(yp[k][j].y);
                    bs[k][j] = bs[k][j] + y * rstd * gpost[j];
                    if constexpr (XOUT) { u32x2 q; q.x = pk2(bs[k][j].x, bs[k][j].y); q.y = pk2(bs[k][j].z, bs[k][j].w); ((u32x2*)(P.Xout + (size_t)m * 1024))[lane + 64 * j] = q;
                        bs[k][j].x = bf_lo(q.x); bs[k][j].y = bf_hi(q.x); bs[k][j].z = bf_lo(q.y); bs[k][j].w = bf_hi(q.y); }
                    else ((f32x4*)(P.out + (size_t)m * 1024))[lane + 64 * j] = bs[k][j];
                    s2[k] += (bs[k][j].x * bs[k][j].x + bs[k][j].y * bs[k][j].y) + (bs[k][j].z * bs[k][j].z + bs[k][j].w * bs[k][j].w); } }
            if constexpr (HOUT) {
#pragma unroll
                for (int off = 1; off < 64; off <<= 1)
#pragma unroll
                    for (int k = 0; k < NR; ++k) s2[k] += __shfl_xor(s2[k], off);
#pragma unroll
                for (int k = 0; k < NR; ++k) { const int m = mr + k; const float rstd2 = rsqrtf(s2[k] * (1.f / 1024.f) + EPS);
#pragma unroll
                    for (int j = 0; j < 4; ++j) { const f32x4 gp = ((const f32x4*)P.wpre)[lane + 64 * j]; u32x2 p; p.x = pk2(bs[k][j].x * rstd2 * gp.x, bs[k][j].y * rstd2 * gp.y); p.y = pk2(bs[k][j].z * rstd2 * gp.z, bs[k][j].w * rstd2 * gp.w);
                        ((u32x2*)(P.Hb + (size_t)m * 1024))[lane + 64 * j] = p; } }
            }
        }
#undef NE_LOAD
        asm volatile("s_waitcnt vmcnt(0) lgkmcnt(0)" ::: "memory");
    }
};


template <int MODE>
struct EpiNormReg {
    static constexpr bool FIRST = MODE == 0, HOUT = MODE != 2;
    static constexpr int MB = FIRST ? 2 : 4;
    static constexpr bool PERM = true, AFTER_DRAIN = false, DEFER = false;
    const float* xp; const float* xs; const bf16_t* Xin; bf16_t* Xout; float* outf; bf16_t* Hb; const float* wpost; const float* wpre;
    float* xb1; unsigned* cnt1; float* xb2; unsigned* cnt2; PG8_LAS unsigned char* tl;
    DI void stats(const f32x4 (&v)[2][2][4][2], const pg8::Unit& u, int wr, int wc, int fr, int fq, float* xb, unsigned* cnt) const {
        PG8_LAS float* Pt = (PG8_LAS float*)tl; PG8_LAS float* St = (PG8_LAS float*)(tl + 4096);
        const int tid = threadIdx.x, wid = tid >> 6, lane = tid & 63;
#pragma unroll
        for (int ai = 0; ai < 2; ++ai)
#pragma unroll
            for (int m = 0; m < 4; ++m) { float q = 0.f;
#pragma unroll
                for (int bj = 0; bj < 2; ++bj)
#pragma unroll
                    for (int n = 0; n < 2; ++n) { const f32x4 x = v[ai][bj][m][n]; q += (x[0] * x[0] + x[1] * x[1]) + (x[2] * x[2] + x[3] * x[3]); }
                q += __shfl_xor(q, 16); q += __shfl_xor(q, 32);
                if (fq == 0) Pt[(ai * 128 + wr * 64 + m * 16 + fr) * 4 + wc] = q; }
        asm volatile("s_waitcnt lgkmcnt(0)" ::: "memory"); __builtin_amdgcn_s_barrier(); asm volatile("" ::: "memory");
        if (tid < 256) { const f32x4 p = *(const PG8_LAS f32x4*)(Pt + tid * 4);
            __hip_atomic_store(xb + (size_t)(u.pm * 256 + tid) * 4 + u.pn, (p[0] + p[1]) + (p[2] + p[3]), __ATOMIC_RELAXED, __HIP_MEMORY_SCOPE_AGENT);
            asm volatile("s_waitcnt vmcnt(0)" ::: "memory");
            if (lane == 0) __hip_atomic_fetch_add(cnt + 16 * u.pm, 1u, __ATOMIC_RELAXED, __HIP_MEMORY_SCOPE_AGENT); }
        if (wid == 0) { unsigned sp = 0;
            while ((unsigned)__builtin_amdgcn_readfirstlane(__hip_atomic_load(cnt + 16 * u.pm, __ATOMIC_RELAXED, __HIP_MEMORY_SCOPE_AGENT)) < 16u) { __builtin_amdgcn_s_sleep(1); if (++sp > (1u << 22)) break; }
            __builtin_amdgcn_fence(__ATOMIC_ACQUIRE, "agent"); }
        asm volatile("s_waitcnt vmcnt(0) lgkmcnt(0)" ::: "memory"); __builtin_amdgcn_s_barrier(); asm volatile("" ::: "memory");
        if (tid < 256) { const float* sl = xb + (size_t)(u.pm * 256 + tid) * 4; float t = 0.f;
#pragma unroll
            for (int k = 0; k < 4; ++k) t += __hip_atomic_load(sl + k, __ATOMIC_RELAXED, __HIP_MEMORY_SCOPE_AGENT);
            St[tid] = rsqrtf(t * (1.f / 1024.f) + EPS); }
        asm volatile("s_waitcnt lgkmcnt(0)" ::: "memory"); __builtin_amdgcn_s_barrier(); asm volatile("" ::: "memory");
    }
    DI void operator()(f32x4 (&acc)[2][2][4][2], const pg8::Unit& u, int wr, int wc, int fr, int fq) const {
        PG8_LAS float* St = (PG8_LAS float*)(tl + 4096);
        const int row0 = u.pm * 256 + wr * 64 + fr, col0 = u.pn * 256 + wc * 32 + 8 * fq;
        f32x4 gp[2][2];
#pragma unroll
        for (int bj = 0; bj < 2; ++bj) { gp[bj][0] = *(const f32x4*)(wpost + col0 + bj * 128); gp[bj][1] = *(const f32x4*)(wpost + col0 + bj * 128 + 4); }
        stats(acc, u, wr, wc, fr, fq, xb1, cnt1);
#pragma unroll
        for (int ab = 0; ab < 8 / MB; ++ab) { const int ai = (ab * MB) >> 2, m0 = (ab * MB) & 3;
            f32x4 bb[FIRST ? MB : 1][2][2]; u32x4 pk[FIRST ? 1 : MB][2];
#pragma unroll
            for (int mm = 0; mm < MB; ++mm) { const int m = m0 + mm; const int row = u.pm * 256 + ai * 128 + wr * 64 + m * 16 + fr;
#pragma unroll
                for (int bj = 0; bj < 2; ++bj) { const int col = col0 + bj * 128;
                    if constexpr (FIRST) { const float* bp = (row < 16 * T ? xp + (size_t)row * 1024 : xs + (size_t)(row - 16 * T) * 1024) + col; bb[mm][bj][0] = *(const f32x4*)bp; bb[mm][bj][1] = *(const f32x4*)(bp + 4); }
                    else pk[mm][bj] = *(const u32x4*)(Xin + (size_t)row * 1024 + col); } }
            asm volatile("" ::: "memory");
#pragma unroll
            for (int mm = 0; mm < MB; ++mm) { const int m = m0 + mm; const int rl = ai * 128 + wr * 64 + m * 16 + fr, row = u.pm * 256 + rl; const float rstd = St[rl];
#pragma unroll
                for (int bj = 0; bj < 2; ++bj) { const int col = col0 + bj * 128;
                    f32x4 b0, b1;
                    if constexpr (FIRST) { b0 = bb[mm][bj][0]; b1 = bb[mm][bj][1]; }
                    else { const u32x4 p = pk[mm][bj]; b0 = (f32x4){bf_lo(p.x), bf_hi(p.x), bf_lo(p.y), bf_hi(p.y)}; b1 = (f32x4){bf_lo(p.z), bf_hi(p.z), bf_lo(p.w), bf_hi(p.w)}; }
                    f32x4 v0 = b0 + acc[ai][bj][m][0] * rstd * gp[bj][0], v1 = b1 + acc[ai][bj][m][1] * rstd * gp[bj][1];
                    if constexpr (MODE == 2) { float* op = outf + (size_t)row * 1024 + col; *(f32x4*)op = v0; *(f32x4*)(op + 4) = v1; }
                    else { u32x4 w; w.x = pk2(v0[0], v0[1]); w.y = pk2(v0[2], v0[3]); w.z = pk2(v1[0], v1[1]); w.w = pk2(v1[2], v1[3]);
                        *(u32x4*)(Xout + (size_t)row * 1024 + col) = w;
                        v0 = (f32x4){bf_lo(w.x), bf_hi(w.x), bf_lo(w.y), bf_hi(w.y)}; v1 = (f32x4){bf_lo(w.z), bf_hi(w.z), bf_lo(w.w), bf_hi(w.w)}; }
                    acc[ai][bj][m][0] = v0; acc[ai][bj][m][1] = v1; } }
            asm volatile("" ::: "memory");
        }
        if constexpr (HOUT) {
#pragma unroll
            for (int bj = 0; bj < 2; ++bj) { gp[bj][0] = *(const f32x4*)(wpre + col0 + bj * 128); gp[bj][1] = *(const f32x4*)(wpre + col0 + bj * 128 + 4); }
            stats(acc, u, wr, wc, fr, fq, xb2, cnt2);
#pragma unroll
            for (int ai = 0; ai < 2; ++ai)
#pragma unroll
                for (int m = 0; m < 4; ++m) { const int rl = ai * 128 + wr * 64 + m * 16 + fr, row = u.pm * 256 + rl; const float rstd = St[rl];
#pragma unroll
                    for (int bj = 0; bj < 2; ++bj) { const int col = col0 + bj * 128;
                        const f32x4 v0 = acc[ai][bj][m][0] * rstd * gp[bj][0], v1 = acc[ai][bj][m][1] * rstd * gp[bj][1];
                        u32x4 w; w.x = pk2(v0[0], v0[1]); w.y = pk2(v0[2], v0[3]); w.z = pk2(v1[0], v1[1]); w.w = pk2(v1[2], v1[3]);
                        *(u32x4*)(Hb + (size_t)row * 1024 + col) = w; } }
        }
    }
};
DI void ph_prologue(const Ctx& c) {
    const int tid = tid_opaque(); const int gw = c.gw, NGW = c.NGW, lane = tid & 63;
    LAS float* scr = (LAS float*)(c.lds + c.wave * 16384);
    const float* w_in = c.in[I_W_IN];
    bf16_t* Win_t = WSP(WS_WIN);
    transpose_seg(w_in, 1024, 6688, 0, 1024, Win_t, 0, 0, 1.f, scr, gw, NGW, lane);
    transpose_seg(w_in, 1024, 6688, 2048, 1024, Win_t, 1024, 0, 1.f, scr, gw, NGW, lane);
    transpose_seg(w_in, 1024, 6688, 3104, 1536, Win_t, 2048, 0, 1.f, scr, gw, NGW, lane);
    transpose_seg(w_in, 1024, 6688, 3072, 32, Win_t, 3584, 0, 1.f, scr, gw, NGW, lane);
    transpose_seg(w_in, 1024, 6688, 4640, 2048, Win_t, 3840, 0, 1.f, scr, gw, NGW, lane);
    transpose_seg(w_in, 1024, 6688, 1024, 1024, WSP(WS_WGV), 0, 0, 1.f, scr, gw, NGW, lane);
    for (int i = c.bx * 512 + tid; i < 224 * 1024 / 8; i += c.G * 512) ((u32x4*)(Win_t + (size_t)3616 * 1024))[i] = (u32x4){0u, 0u, 0u, 0u};
    transpose_seg(c.in[I_W_BR_GLA], 1024, 1024, 0, 1024, WSP(WS_WA), 0, 0, 1.f, scr, gw, NGW, lane);
    transpose_seg(c.in[I_W_BR_ATT], 1024, 1024, 0, 1024, WSP(WS_WB), 0, 0, 1.f, scr, gw, NGW, lane);
    transpose_seg(c.in[I_W_OUT], 1024, 1024, 0, 1024, WSP(WS_WOUT), 0, 0, 1.f, scr, gw, NGW, lane);
    transpose_seg(c.in[I_X_WQ], 1024, 1024, 0, 1024, WSP(WS_WQ), 0, 0, 0.0625f, scr, gw, NGW, lane);
    transpose_seg(c.in[I_X_WKV], 1024, 2048, 0, 2048, WSP(WS_WKV), 0, 0, 1.f, scr, gw, NGW, lane);
    transpose_seg(c.in[I_X_WO], 1024, 1024, 0, 1024, WSP(WS_WO), 0, 0, 1.f, scr, gw, NGW, lane);
    transpose_seg(c.in[I_FFN_WI], 1024, 2 * DFF, 0, 2 * DFF, WSP(WS_WI), 0, 1, 1.f, scr, gw, NGW, lane);
    transpose_seg(c.in[I_FFN_WO], DFF, 1024, 0, 1024, WSP(WS_WO2), 0, 0, 1.f, scr, gw, NGW, lane);
    float* TAB = (float*)(c.ws + WS_TAB);
    for (int i = c.bx * 512 + tid; i < 64 * 32; i += c.G * 512) { const int pos = i >> 5, f = i & 31;
        const float inv = powf(10000.f, -(float)(2 * f) / 64.f); const float ang = (float)pos * inv;
        TAB[i] = cosf(ang); TAB[2048 + i] = sinf(ang); }
    bf16_t* MEMN = (bf16_t*)((char*)c.out + 64 * MiB);
    for (int m = gw; m < MMEM; m += NGW) { const float* mr = m < 16 * NMEM ? c.in[I_MP] + (size_t)m * 1024 : c.in[I_MS] + (size_t)(m - 16 * NMEM) * 1024;
        rms_row_to_bf16(mr, c.in[I_LN_MEM], MEMN + (size_t)m * 1024, lane); }
    rms_rows_to_bf16(c, 0, MR, c.in[I_LN_MIX_PRE], WSP(WS_XN), lane, gw, NGW);
}
DI void ph_inproj(const Ctx& c, int r, int gemm_rep) {
    { EpiProj e{WSP(WS_PROJ), WSP(WS_GATES) + (size_t)r * MR * 2048}; GEMM(EpiProj, e, WSP(WS_XN), 1024, WSP(WS_WIN), 1024, MR, N1, 1024); }
    { EpiStore e{WSP(WS_GVT), MR}; GEMM(EpiStore, e, WSP(WS_WGV), 1024, WSP(WS_XN), 1024, 1024, MR, 1024); }
}
DI void ph_memkv(const Ctx& c, int r, int gemm_rep) {
    bf16_t* MEMN = (bf16_t*)((char*)c.out + 64 * MiB) + (size_t)r * 2048 * 1024;
    int bxs = (c.bx + 64) % c.G;
#define GEMM_S(EPI, e, Ap, lda_, Bp, ldb_, M_, N_, K_) do { pg8::Gemm g_{Ap, Bp, M_, N_, K_, lda_, ldb_}; pg8::StaticOrder S_; S_.init(M_, N_, c.G, bxs); S_.rep = gemm_rep; \
        if (EN_GEMM) pg8::gemm_phase<EPI, pg8::StaticOrder, true, true>(c.lds, g_, S_, e); } while (0)
    { EpiStore e{WSP(WS_KMEM) + (size_t)r * 2048 * 1024, 1024}; GEMM_S(EpiStore, e, MEMN, 1024, WSP(WS_WKV), 1024, 2048, 1024, 1024); }
    bxs = (c.bx + 32) % c.G;
    { EpiStore e{WSP(WS_VTMEM) + (size_t)r * 2048, MMEM}; GEMM_S(EpiStore, e, WSP(WS_WKV) + (size_t)1024 * 1024, 1024, MEMN, 1024, 1024, 2048, 1024); }
#undef GEMM_S
}
DI void kprep_item(const Ctx& c, int bl, int ch, int lane) {
    const float* kn = c.in[I_KNORM]; const float* TAB = (const float*)(c.ws + WS_TAB);
    const int sub = lane >> 4, q = lane & 15, blk = q >> 3, fb = (q & 7) * 4;
    const f32x4 g1 = *(const f32x4*)(kn + 64 * blk + fb), g2 = *(const f32x4*)(kn + 64 * blk + 32 + fb);
    constexpr int NIT = 4;
    const int grp0 = (bl * T + ch * 256) * 2 / 4;
    for (int i0 = c.wave * NIT; i0 < 128; i0 += 8 * NIT) {
        u32x2 a[NIT], b[NIT]; bf16_t* pp[NIT]; int tt[NIT];
#pragma unroll
        for (int k = 0; k < NIT; ++k) { const int row = (grp0 + i0 + k) * 4 + sub; const int t = row >> 1, hd = row & 1; tt[k] = t & (T - 1);
            pp[k] = WSP(WS_PROJ) + (size_t)t * LDP + PC_AK + hd * 128 + 64 * blk + fb;
            a[k] = *(const u32x2*)pp[k]; b[k] = *(const u32x2*)(pp[k] + 32); }
#pragma unroll
        for (int k = 0; k < NIT; ++k) {
            float x1[4] = {bf_lo(a[k].x), bf_hi(a[k].x), bf_lo(a[k].y), bf_hi(a[k].y)}, x2[4] = {bf_lo(b[k].x), bf_hi(b[k].x), bf_lo(b[k].y), bf_hi(b[k].y)};
            float ss = (x1[0] * x1[0] + x1[1] * x1[1]) + (x1[2] * x1[2] + x1[3] * x1[3]) + (x2[0] * x2[0] + x2[1] * x2[1]) + (x2[2] * x2[2] + x2[3] * x2[3]);
            ss += __shfl_xor(ss, 1); ss += __shfl_xor(ss, 2); ss += __shfl_xor(ss, 4); ss += __shfl_xor(ss, 8);
            const float rstd = rsqrtf(ss * (1.f / 128.f) + EPS);
            const int pos = blk ? (tt[k] & 63) : (tt[k] >> 6);
            const f32x4 cs = *(const f32x4*)(TAB + pos * 32 + fb), sn = *(const f32x4*)(TAB + 2048 + pos * 32 + fb);
            float o1[4], o2[4];
#pragma unroll
            for (int x = 0; x < 4; ++x) { const float u = x1[x] * rstd * g1[x], v = x2[x] * rstd * g2[x]; o1[x] = u * cs[x] - v * sn[x]; o2[x] = v * cs[x] + u * sn[x]; }
            u32x2 w1, w2; w1.x = pk2(o1[0], o1[1]); w1.y = pk2(o1[2], o1[3]); w2.x = pk2(o2[0], o2[1]); w2.y = pk2(o2[2], o2[3]);
            *(u32x2*)pp[k] = w1; *(u32x2*)(pp[k] + 32) = w2; }
    }
}
DI void combine_item(const Ctx& c, int r, int bl, int tch, int lane) {
    const float* gn = c.in[I_GLA_NORM];
    bf16_t* OFB = WSP(WS_OFB); bf16_t* PROJ = WSP(WS_PROJ); bf16_t* GLA_O = (bf16_t*)c.out;
    const f32x4 g = *(const f32x4*)(gn + lane * 4);
    constexpr int NIT = 8;
    const int base = (bl * T + tch * 64) * 4;
    for (int i0 = c.wave * NIT; i0 < 256; i0 += 8 * NIT) {
        u32x2 a[NIT], b[NIT], rr[NIT];
#pragma unroll
        for (int k = 0; k < NIT; ++k) { const int it = base + i0 + k, t = it >> 2, h = it & 3;
            a[k] = *(const u32x2*)(OFB + (size_t)t * 1024 + h * 256 + lane * 4); b[k] = *(const u32x2*)(OFB + (size_t)(MR + t) * 1024 + h * 256 + lane * 4);
            rr[k] = *(const u32x2*)(PROJ + (size_t)t * LDP + PC_GR + h * 256 + lane * 4); }
        float o[NIT][4], ss[NIT];
#pragma unroll
        for (int k = 0; k < NIT; ++k) { o[k][0] = bf_lo(a[k].x) + bf_lo(b[k].x); o[k][1] = bf_hi(a[k].x) + bf_hi(b[k].x); o[k][2] = bf_lo(a[k].y) + bf_lo(b[k].y); o[k][3] = bf_hi(a[k].y) + bf_hi(b[k].y);
            ss[k] = (o[k][0] * o[k][0] + o[k][1] * o[k][1]) + (o[k][2] * o[k][2] + o[k][3] * o[k][3]); }
#pragma unroll
        for (int off = 1; off < 64; off <<= 1)
#pragma unroll
            for (int k = 0; k < NIT; ++k) ss[k] += __shfl_xor(ss[k], off);
#pragma unroll
        for (int k = 0; k < NIT; ++k) { const int it = base + i0 + k, t = it >> 2, h = it & 3;
            const float rstd = rsqrtf(ss[k] * (1.f / 256.f) + EPS);
            const float rv[4] = {bf_lo(rr[k].x), bf_hi(rr[k].x), bf_lo(rr[k].y), bf_hi(rr[k].y)};
            float v[4];
#pragma unroll
            for (int j = 0; j < 4; ++j) v[j] = o[k][j] * rstd * g[j] * (rv[j] * sigmoidf_(rv[j]));
            u32x2 w; w.x = pk2(v[0], v[1]); w.y = pk2(v[2], v[3]);
            *(u32x2*)(GLA_O + (size_t)(r * MR + t) * 1024 + h * 256 + lane * 4) = w; }
    }
}
DI void ph_mixers(const Ctx& c, int r) {
    const int tid = tid_opaque();
    LAS int* qslot = (LAS int*)(c.lds + LDS_MISC);
    unsigned* CTL = (unsigned*)(c.ws + WS_CTL);
    bf16_t* PROJ = WSP(WS_PROJ); bf16_t* ATT_O = (bf16_t*)c.out + (size_t)MTOT * 1024;
    for (;;) {
        __syncthreads();
        if (tid == 0) *qslot = (int)atomicAdd(CTL + 64 * (1 + 2 * r), 1u);
        __syncthreads();
        const int it = *qslot;
        if (it >= 64) break;
        const int bl = it >> 3, h = (it >> 1) & 3, dir = it & 1;
        if (EN_GLA) gla::item((LAS char*)c.lds, PROJ, WSP(WS_GVT), WSP(WS_OFB) + (size_t)dir * MR * 1024, c.in[dir ? I_WA_B : I_WA_F], c.in[dir ? I_BA_B : I_BA_F], bl, h, dir);
        asm volatile("s_waitcnt vmcnt(0)" ::: "memory");
        __syncthreads();
        if (tid == 0) { __builtin_amdgcn_fence(__ATOMIC_RELEASE, "agent"); asm volatile("s_waitcnt vmcnt(0)" ::: "memory");
            __hip_atomic_fetch_add(CTL + 1024 + r * 8 + bl, 1u, __ATOMIC_RELAXED, __HIP_MEMORY_SCOPE_AGENT); }
    }
    for (;;) {
        __syncthreads();
        if (tid == 0) *qslot = (int)atomicAdd(CTL + 64 * (10 + r), 1u);
        __syncthreads();
        const int it = *qslot;
        if (it >= 64) break;
        kprep_item(c, it >> 3, it & 7, tid & 63);
        asm volatile("s_waitcnt vmcnt(0)" ::: "memory");
        __syncthreads();
        if (tid == 0) { __builtin_amdgcn_fence(__ATOMIC_RELEASE, "agent"); asm volatile("s_waitcnt vmcnt(0)" ::: "memory");
            __hip_atomic_fetch_add(CTL + 1088 + r * 8 + (it >> 3), 1u, __ATOMIC_RELAXED, __HIP_MEMORY_SCOPE_AGENT); }
    }
    const int myx = (int)((unsigned)__builtin_amdgcn_s_getreg((3 << 11) | 20) & 7u);
    for (int kq = 0; kq < 8; ++kq) {
        const int qx = (myx + kq) & 7;
        for (;;) {
            __syncthreads();
            if (tid == 0) *qslot = (int)atomicAdd(CTL + 2048 + (r * 8 + qx) * 64, 1u);
            __syncthreads();
            const int uq = *qslot;
            if (uq >= 64) break;
            const int u = qx * 64 + uq;
            const int bl = u >> 6, hq = (u >> 3) & 7, qb = u & 7, kvh = hq >> 2;
            if (tid == 0) { while (__hip_atomic_load(CTL + 1088 + r * 8 + bl, __ATOMIC_RELAXED, __HIP_MEMORY_SCOPE_AGENT) < 8u) __builtin_amdgcn_s_sleep(2);
                __builtin_amdgcn_fence(__ATOMIC_ACQUIRE, "agent"); asm volatile("s_waitcnt vmcnt(0)" ::: "memory"); }
            __syncthreads();
            const bf16_t* pb = PROJ + (size_t)(bl * T) * LDP;
            if (EN_ATT) att::attn_dense_body<LDP, LDP, 1024>(pb + (size_t)(qb * 256) * LDP + PC_AQ + hq * 128, pb + PC_AK + kvh * 128, pb + PC_AV + kvh * 128,
                                                 ATT_O + (size_t)(r * MR + bl * T + qb * 256) * 1024 + hq * 128, T, (LAS char*)c.lds, c.in[I_QNORM], (const float*)(c.ws + WS_TAB), qb * 256);
        }
    }
    const int lane = tid & 63;
    const int nxn = (r < 2 ? 64 : 0), nlight = nxn + 256;
    for (;;) {
        __syncthreads();
        if (tid == 0) *qslot = (int)atomicAdd(CTL + 64 * (7 + r), 1u);
        __syncthreads();
        const int it = *qslot;
        if (it >= nlight) break;
        if (it < nxn) {
            rms_rows_to_bf16(c, (r + 1) * MR + it * 256, 256, c.in[I_LN_MIX_PRE], WSP(WS_XN) + (size_t)it * 256 * 1024, lane, c.wave, 8);
        } else { const int ci = it - nxn, bl = ci >> 5, tch = ci & 31;
            if (tid == 0) { while (__hip_atomic_load(CTL + 1024 + r * 8 + bl, __ATOMIC_RELAXED, __HIP_MEMORY_SCOPE_AGENT) < 8u) __builtin_amdgcn_s_sleep(4);
                __builtin_amdgcn_fence(__ATOMIC_ACQUIRE, "agent"); asm volatile("s_waitcnt vmcnt(0)" ::: "memory"); }
            __syncthreads();
            combine_item(c, r, bl, tch, lane);
        }
    }
}
DI void ph_cross(const Ctx& c) {
    for (int u = c.bx; u < NBATCH * 4 * 8; u += c.G) { const int b = u >> 5, hx = (u >> 3) & 3, qb = u & 7;
        if (EN_XAT) xat::unit((LAS char*)c.lds, WSP(WS_QX), WSP(WS_KMEM), WSP(WS_VTMEM), WSP(WS_OX), b, hx, qb); }
}

#define XB_TMO      128
#define XB_XCNT(j)  (256  + 64 * (j))
#define XB_XSUB(j)  (1280 + 64 * (j))
#define XB_XGEN(j)  (2304 + 64 * (j))
#define XB_TOP      3328
#define XB_TOPGEN   3392
#define XCD_BAR_WORDS 3456
#define XB_SPIN_CAP (1u << 22)
DI unsigned xb_ld(unsigned* p)              { return __hip_atomic_load(p, __ATOMIC_RELAXED, __HIP_MEMORY_SCOPE_AGENT); }
DI unsigned xb_add(unsigned* p, unsigned v) { return __hip_atomic_fetch_add(p, v, __ATOMIC_RELAXED, __HIP_MEMORY_SCOPE_AGENT); }
DI unsigned xb_xcc_id() { return (unsigned)__builtin_amdgcn_s_getreg((3 << 11) | 20) & 0xFu; }
#define XB_SPIN(cond, bar) do { unsigned _sp = 0; while (cond) { __builtin_amdgcn_s_sleep(1); \
    if ((++_sp & 255u) == 0u) { if (xb_ld(&(bar)[XB_TMO])) break; if (_sp > XB_SPIN_CAP) { atomicAdd(&(bar)[XB_TMO], 1u); break; } } } } while (0)
struct XcdBarrier { unsigned* bar; unsigned x; volatile LAS unsigned* st; };
DI XcdBarrier xcd_barrier_post(unsigned* bar, volatile LAS unsigned* st) {
    XcdBarrier b; b.bar = bar; b.x = xb_xcc_id(); b.st = st;
    if (threadIdx.x == 0) (void)xb_add(&bar[XB_XCNT(b.x)], 1u);
    return b;
}
DI void xcd_barrier_complete(unsigned* bar, unsigned x, unsigned& nloc, unsigned& nx) {
    const unsigned G = gridDim.x * gridDim.y * gridDim.z;
    unsigned sum, cnt, mine, sp = 0u;
    for (;;) {
        sum = 0u; cnt = 0u; mine = 0u;
#pragma unroll
        for (unsigned j = 0; j < 16; ++j) { const unsigned c = xb_ld(&bar[XB_XCNT(j)]); sum += c; cnt += (c > 0u) ? 1u : 0u; mine = (j == x) ? c : mine; }
        if (sum == G) break;
        __builtin_amdgcn_s_sleep(1);
        if ((++sp & 255u) == 0u) { if (xb_ld(&bar[XB_TMO])) break; if (sp > XB_SPIN_CAP) { atomicAdd(&bar[XB_TMO], 1u); break; } }
    }
    nloc = mine > 0u ? mine : 1u; nx = cnt > 0u ? cnt : 1u;
}
DI void xcd_barrier(const XcdBarrier& b) {
    asm volatile("s_waitcnt vmcnt(0)" ::: "memory");
    __syncthreads();
    if (threadIdx.x == 0) {
        unsigned* bar = b.bar;
        __builtin_amdgcn_s_waitcnt(0);
        unsigned nloc = b.st[0], nx = b.st[1];
        if (nloc == 0u) { xcd_barrier_complete(bar, b.x, nloc, nx); b.st[0] = nloc; b.st[1] = nx; }
        const unsigned old = xb_add(&bar[XB_XSUB(b.x)], 1u);
        const unsigned gen = old / nloc;
        if (old + 1u == (gen + 1u) * nloc) {
            __builtin_amdgcn_fence(__ATOMIC_RELEASE, "agent");
            asm volatile("s_waitcnt vmcnt(0)" ::: "memory");
            const unsigned og = xb_add(&bar[XB_TOP], 1u);
            const unsigned tg = og / nx;
            if (og + 1u == (tg + 1u) * nx) xb_add(&bar[XB_TOPGEN], 1u);
            else XB_SPIN(xb_ld(&bar[XB_TOPGEN]) == tg, bar);
            __builtin_amdgcn_fence(__ATOMIC_ACQUIRE, "agent");
            xb_add(&bar[XB_XGEN(b.x)], 1u);
            asm volatile("s_waitcnt vmcnt(0)" ::: "memory");
        } else {
            XB_SPIN(xb_ld(&bar[XB_XGEN(b.x)]) == gen, bar);
            __builtin_amdgcn_fence(__ATOMIC_ACQUIRE, "agent");
            asm volatile("s_waitcnt vmcnt(0)" ::: "memory");
        }
    }
    __syncthreads();
}
DI void grid_bar(unsigned* ctr, unsigned target) {
    asm volatile("s_waitcnt vmcnt(0)" ::: "memory");
    __syncthreads();
    if (threadIdx.x == 0) {
        __builtin_amdgcn_fence(__ATOMIC_RELEASE, "agent");
        asm volatile("s_waitcnt vmcnt(0)" ::: "memory");
        __hip_atomic_fetch_add(ctr, 1u, __ATOMIC_RELAXED, __HIP_MEMORY_SCOPE_AGENT);
        while (__hip_atomic_load(ctr, __ATOMIC_RELAXED, __HIP_MEMORY_SCOPE_AGENT) < target) __builtin_amdgcn_s_sleep(2);
        __builtin_amdgcn_fence(__ATOMIC_ACQUIRE, "agent");
        asm volatile("s_waitcnt vmcnt(0)" ::: "memory");
    }
    __syncthreads();
}
__global__ void __launch_bounds__(512) fwd(Args args) {
    extern __shared__ __attribute__((aligned(16))) unsigned char lds_raw[];
    Ctx c;
    c.lds = (LAS unsigned char*)lds_raw;
    c.wave = __builtin_amdgcn_readfirstlane(threadIdx.x >> 6);
    c.G = gridDim.x; c.bx = blockIdx.x; c.gw = c.bx * 8 + c.wave; c.NGW = c.G * 8;
    c.in = args.in; c.out = args.out; c.ws = args.ws;
    cg::grid_group grid = cg::this_grid();
    const int lo = args.ph_lo, hi = args.ph_hi;
    volatile LAS unsigned* xst = (volatile LAS unsigned*)(c.lds + LDS_MISC + 128);
    if (threadIdx.x < 2) xst[threadIdx.x] = 0u;
    __syncthreads();
    XcdBarrier xbar; xbar.bar = (unsigned*)(c.ws + WS_CTL) + 4096; xbar.x = 0; xbar.st = xst;
    if (hi - lo > 1) xbar = xcd_barrier_post((unsigned*)(c.ws + WS_CTL) + 4096, xst);
    int gemm_rep = 1;
#define IN(k) (lo <= (k) && (k) < hi)
#define SEAM(k) do { if (IN(k) && IN((k) + 1)) { if (args.ph_hi < 0) grid.sync(); else xcd_barrier(xbar); } } while (0)
    if (IN(0)) ph_prologue(c);
    SEAM(0);
#define ROUND(r) \
    if (IN(1 + 2 * (r))) { ph_inproj(c, r, REP_INPROJ(r)); ph_memkv(c, r, REP_INPROJ(r)); } SEAM(1 + 2 * (r)); \
    if (IN(2 + 2 * (r))) ph_mixers(c, r); SEAM(2 + 2 * (r));
    ROUND(0) ROUND(1) ROUND(2)
    if (IN(7)) { EpiGate e{WSP(WS_GATES), 0}; GEMM(EpiGate, e, (bf16_t*)c.out, 1024, WSP(WS_WA), 1024, MTOT, 1024, 1024);
        asm volatile("s_waitcnt vmcnt(0)" ::: "memory"); __syncthreads();
        if (threadIdx.x == 0) { __builtin_amdgcn_fence(__ATOMIC_ACQUIRE, "agent"); asm volatile("s_waitcnt vmcnt(0)" ::: "memory"); }
        __syncthreads();
        EpiGate e2{WSP(WS_GATES), 1}; GEMM(EpiGate, e2, (bf16_t*)c.out + (size_t)MTOT * 1024, 1024, WSP(WS_WB), 1024, MTOT, 1024, 1024); }
    SEAM(7);
    bf16_t* XB1 = (bf16_t*)c.out; bf16_t* XB2 = WSP(408 * MiB); bf16_t* H3 = WSP(312 * MiB); bf16_t* Y2 = WSP(48 * MiB); bf16_t* Y3 = WSP(312 * MiB);
#define NREG(MODE_, cb, wpost_, wpre_, Hp, Xin_, Xout_) EpiNormReg<MODE_>{c.in[I_XP], c.in[I_XS], Xin_, Xout_, c.out, Hp, wpost_, wpre_, \
        (float*)(c.ws + WS_CTL + 131072), (unsigned*)(c.ws + WS_CTL) + (cb), (float*)((char*)c.out + 96 * MiB), (unsigned*)(c.ws + WS_CTL) + (cb) + 3072, (PG8_LAS unsigned char*)(c.lds + 131072 + 8192)}
    if (IN(8)) { EpiNormReg<0> e = NREG(0, 8192, c.in[I_LN_MIX_POST], c.in[I_LN_X_PRE], WSP(WS_H), nullptr, XB1); GEMM(EpiNormReg<0>, e, WSP(WS_GATES), 2048, WSP(WS_WOUT), 1024, MTOT, 1024, 1024); } SEAM(8);
    gemm_rep = REP_N1024; if (IN(9)) { EpiStore e{WSP(WS_QX), 1024}; GEMM(EpiStore, e, WSP(WS_H), 1024, WSP(WS_WQ), 1024, MTOT, 1024, 1024); } gemm_rep = 1; SEAM(9);
    if (IN(10)) ph_cross(c); SEAM(10);
    if (IN(11)) { EpiNormReg<1> e = NREG(1, 8192 + 6144, c.in[I_LN_X_POST], c.in[I_LN_FFN_PRE], H3, XB1, XB2); GEMM(EpiNormReg<1>, e, WSP(WS_OX), 1024, WSP(WS_WO), 1024, MTOT, 1024, 1024); } SEAM(11);
    if (IN(12)) { EpiSwiglu e{WSP(WS_ACT)}; GEMM(EpiSwiglu, e, H3, 1024, WSP(WS_WI), 1024, MTOT, 2 * DFF, 1024); } SEAM(12);
    if (IN(13)) { EpiNormReg<2> e = NREG(2, 8192 + 12288, c.in[I_LN_FFN_POST], nullptr, nullptr, XB2, nullptr); GEMM(EpiNormReg<2>, e, WSP(WS_ACT), DFF, WSP(WS_WO2), DFF, MTOT, 1024, DFF); }
}

#ifndef N_LAUNCH_MODE
#define N_LAUNCH_MODE 0
#endif
extern "C" void kernel_launch(void* const* d_in, const int* in_sizes, int n_in, void* d_out, int out_size, void* d_ws, size_t ws_size, hipStream_t stream) {
    static int grid = 0;
    if (grid == 0) {
        if (n_in != 27 || out_size != MTOT * 1024 || ws_size < WS_END) { fprintf(stderr, "kernel_launch: unexpected shapes: n_in %d out %d ws %zu (need %zu)\n", n_in, out_size, ws_size, (size_t)WS_END); grid = -1; return; }
        int dev = 0, cus = 0, per_cu = 0;
        hipGetDevice(&dev); hipDeviceGetAttribute(&cus, hipDeviceAttributeMultiprocessorCount, dev);
        if (hipFuncSetAttribute((const void*)fwd, hipFuncAttributeMaxDynamicSharedMemorySize, LDS_BYTES) != hipSuccess) { fprintf(stderr, "kernel_launch: hipFuncSetAttribute failed\n"); grid = -1; return; }
        if (hipOccupancyMaxActiveBlocksPerMultiprocessor(&per_cu, (const void*)fwd, 512, LDS_BYTES) != hipSuccess || per_cu < 1) { fprintf(stderr, "kernel_launch: occupancy query says %d\n", per_cu); per_cu = 1; }
        (void)hipGetLastError();
        grid = cus * 1;
    }
    if (grid < 0) return;
    hipMemsetAsync((char*)d_ws + WS_CTL, 0, 131072, stream);
    Args a{};
    for (int i = 0; i < 27; ++i) a.in[i] = (const float*)d_in[i];
    a.out = (float*)d_out; a.ws = (unsigned char*)d_ws;
#if N_LAUNCH_MODE == 0
    a.ph_lo = 0; a.ph_hi = NPHASE;
    void* kargs[] = {&a};
    hipError_t e = hipLaunchCooperativeKernel((const void*)fwd, dim3(grid), dim3(512), kargs, LDS_BYTES, stream);
    if (e != hipSuccess) fprintf(stderr, "cooperative launch failed: %s (grid %d)\n", hipGetErrorString(e), grid);
#else
    for (int ph = 0; ph < NPHASE; ++ph) { a.ph_lo = ph; a.ph_hi = ph + 1; hipLaunchKernelGGL(fwd, dim3(grid), dim3(512), LDS_BYTES, stream, a); }
    hipError_t e = hipPeekAtLastError();
    if (e != hipSuccess) fprintf(stderr, "launch failed: %s\n", hipGetErrorString(e));
#endif
}
```

```cpp
#include <hip/hip_runtime.h>
#include <hip/hip_cooperative_groups.h>
#include <cstdio>
#include <cstdint>
namespace cg = cooperative_groups;

#define LAS __attribute__((address_space(3)))
typedef unsigned short bf16_t;
typedef short bf16x8 __attribute__((ext_vector_type(8)));
typedef float f32x2 __attribute__((ext_vector_type(2)));
typedef float f32x4 __attribute__((ext_vector_type(4)));
typedef float f32x16 __attribute__((ext_vector_type(16)));
typedef unsigned u32x2 __attribute__((ext_vector_type(2)));
typedef unsigned u32x4 __attribute__((ext_vector_type(4)));
typedef __bf16 bf16v2 __attribute__((ext_vector_type(2)));
#define DI __device__ __forceinline__
#define MFMA32(a, b, c) __builtin_amdgcn_mfma_f32_32x32x16_bf16((a), (b), (c), 0, 0, 0)

DI unsigned pk2(float lo, float hi) { f32x2 v = {lo, hi}; bf16v2 r = __builtin_convertvector(v, bf16v2); return __builtin_bit_cast(unsigned, r); }
DI bf16_t f2bf(float f) { return (bf16_t)(pk2(f, 0.f) & 0xffffu); }
DI float bf_lo(unsigned u) { return __uint_as_float(u << 16); }
DI float bf_hi(unsigned u) { return __uint_as_float(u & 0xffff0000u); }
DI float bf2f(bf16_t v) { return __uint_as_float(((unsigned)v) << 16); }
DI float sigmoidf_(float v) { return __builtin_amdgcn_rcpf(1.f + __expf(-v)); }
DI int tid_opaque() { int t = threadIdx.x; asm volatile("" : "+v"(t)); return t; }
DI int crow(int r, int hi) { return (r & 3) + 8 * (r >> 2) + 4 * hi; }
DI float wave_sum(float v) {
#pragma unroll
    for (int o = 1; o < 64; o <<= 1) v += __shfl_xor(v, o);
    return v;
}

constexpr int DM = 1024, NBATCH = 24, T = 2048, MTOT = NBATCH * T, RB = 8, MR = RB * T, NROUND = 3, NMEM = 256, MMEM = NBATCH * NMEM;
constexpr int DFF = 2816;
constexpr int LDP = 3840;
constexpr int PC_GQ = 0, PC_GK = 512, PC_GR = 1024, PC_AQ = 2048, PC_AK = 3072, PC_AV = 3328, PC_Z = 3584;
constexpr int NPROJ_TILES = 15, N1 = 23 * 256;
constexpr float EPS = 1e-6f;
constexpr size_t MiB = 1u << 20;
constexpr size_t WS_CTL = 0;
constexpr size_t WS_WIN = 1 * MiB;
constexpr size_t WS_WGV = WS_WIN + (size_t)N1 * 1024 * 2;
constexpr size_t WS_WA = WS_WGV + 2 * MiB, WS_WB = WS_WA + 2 * MiB, WS_WOUT = WS_WB + 2 * MiB, WS_WQ = WS_WOUT + 2 * MiB;
constexpr size_t WS_WKV = WS_WQ + 2 * MiB, WS_WO = WS_WKV + 4 * MiB, WS_WI = WS_WO + 2 * MiB, WS_WO2 = WS_WI + 11 * MiB;
constexpr size_t WS_TAB = WS_WO2 + 6 * MiB;
static_assert(WS_TAB + 65536 <= 48 * MiB, "weights region");
constexpr size_t WS_R = 48 * MiB;
constexpr size_t WS_GATES = WS_R;
constexpr size_t WS_PROJ = WS_R + 192 * MiB;
constexpr size_t WS_GVT = WS_PROJ + 120 * MiB;
constexpr size_t WS_XN = WS_GVT + 32 * MiB;
constexpr size_t WS_OFB = WS_XN + 32 * MiB;
constexpr size_t WS_KMEM = WS_OFB + 64 * MiB;
constexpr size_t WS_VTMEM = WS_KMEM + 12 * MiB;
constexpr size_t WS_END = WS_VTMEM + 12 * MiB;
static_assert(WS_END == 512 * MiB, "ws map");
constexpr size_t WS_Y = WS_R + 192 * MiB;
constexpr size_t WS_H = WS_R + 288 * MiB;
constexpr size_t WS_QX = WS_R;
constexpr size_t WS_OX = WS_R + 96 * MiB;
constexpr size_t WS_ACT = WS_R;
static_assert(WS_ACT + (size_t)MTOT * DFF * 2 <= WS_H, "act overlay");
static_assert(WS_H + 96 * MiB <= WS_KMEM, "H overlay");
constexpr int LDS_BYTES = 147456;
constexpr int LDS_MISC = 147456 - 256;

namespace pg8 {
#define PG8_LAS __attribute__((address_space(3)))
constexpr int BM = 256, BK = 64, HALF = 128, HTB = HALF * BK * 2, STAGE_BYTES = 8 * HTB, NXCD = 8, WGM = 8;
__host__ __device__ __forceinline__ int lds_byte(int r, int c) { const int st = (r >> 4) * 2 + (c >> 5), rr = r & 15, cc = c & 31, ob = rr * 64 + cc * 2; return st * 1024 + (ob ^ (((ob >> 9) & 1) << 5)); }
__host__ __device__ __forceinline__ void stage_rc(int b, int& R, int& C) { const int st = b / 1024, sb = b % 1024, swz = sb ^ (((sb >> 9) & 1) << 5); R = (st >> 1) * 16 + swz / 64; C = (st & 1) * 32 + (swz % 64) / 2; }
__host__ __device__ __forceinline__ int perm32(int rho) { const int n = rho >> 4, i = rho & 15; return 8 * (i >> 2) + 4 * n + (i & 3); }
struct Unit { int pm, pn; };
struct Gemm { const bf16_t* A; const bf16_t* Bt; int M, N, K, lda, ldb; };
struct StaticOrder {
    int nM, nN, nwg, G, c, rep = 1;
    __host__ __device__ void init(int M, int N, int G_, int c_) { nM = M / BM; nN = N / BM; nwg = nM * nN; G = G_; c = c_; }
    __host__ __device__ bool next(int i, Unit& u) const {
        const long L = (long)i * G + c; if (L >= (long)nwg * rep) return false;
        int wgid = (int)(L % nwg); { const int q = nwg / NXCD, r = nwg % NXCD, xcd = wgid % NXCD, off = wgid / NXCD; wgid = (xcd < r ? xcd * (q + 1) : r * (q + 1) + (xcd - r) * q) + off; }
        const int nig = WGM * nN, gid = wgid / nig, fm = gid * WGM, gsz = (nM - fm) < WGM ? (nM - fm) : WGM;
        u.pm = fm + ((wgid % nig) % gsz); u.pn = (wgid % nig) / gsz; return true;
    }
    __device__ __forceinline__ void a_ready(const Unit&) const {}
    __device__ __forceinline__ void done(const Unit&) const {}
};
template <class Epi, class Sched, bool ALIGN_EPI = false, bool SP2 = false>
__device__ __forceinline__ void gemm_phase(PG8_LAS unsigned char* lds, const Gemm g, const Sched& S, const Epi& E) {
    const int tid = threadIdx.x, wid = __builtin_amdgcn_readfirstlane(tid >> 6), lane = tid & 63, wr = wid >> 2, wc = wid & 3, fr = lane & 15, fq = lane >> 4;
    const int K = g.K, nt = K / BK;
    unsigned voffA[2], voffB[2];
#pragma unroll
    for (int i = 0; i < 2; ++i) { int R, C; stage_rc(tid * 16 + i * 8192, R, C); const int Rb = Epi::PERM ? ((R & ~31) + perm32(R & 31)) : R;
        voffA[i] = (unsigned)(R * g.lda + C) * 2u; voffB[i] = (unsigned)(Rb * g.ldb + C) * 2u; }
    const size_t kstep = (size_t)(BK * 2);
    const size_t hstepA = (size_t)HALF * g.lda * 2, hstepB = (size_t)HALF * g.ldb * 2;
    const size_t tstepA = 2 * hstepA, tstepB = 2 * hstepB;
    const unsigned ldsw = (unsigned)wid * 1024u;
    const int aoff = lds_byte(wr * 64 + fr, fq * 8), boff = lds_byte(wc * 32 + fr, fq * 8);
#define PG8_SA(b, h) (((b) * 2 + (h)) * HTB)
#define PG8_SB(b, h) ((4 + (b) * 2 + (h)) * HTB)
#define PG8_STAGE(bufoff, gbase, voff) do { _Pragma("unroll") for (int _i = 0; _i < 2; ++_i) \
        __builtin_amdgcn_global_load_lds((const unsigned*)((const char*)(gbase) + (voff)[_i]), (PG8_LAS unsigned*)(lds + (bufoff) + ldsw + _i * 8192), 16, 0, 0); } while (0)
#define PG8_LDA(dst, b, h) do { _Pragma("unroll") for (int m = 0; m < 4; ++m) _Pragma("unroll") for (int k = 0; k < 2; ++k) dst[m][k] = *(const PG8_LAS bf16x8*)(lds + PG8_SA(b, h) + aoff + m * 2048 + k * 1024); } while (0)
#define PG8_LDB(dst, b, h) do { _Pragma("unroll") for (int n = 0; n < 2; ++n) _Pragma("unroll") for (int k = 0; k < 2; ++k) dst[n][k] = *(const PG8_LAS bf16x8*)(lds + PG8_SB(b, h) + boff + n * 2048 + k * 1024); } while (0)
#define PG8_MMA(ai, bj, At, Bt) do { __builtin_amdgcn_s_setprio(1); _Pragma("unroll") for (int m = 0; m < 4; ++m) _Pragma("unroll") for (int n = 0; n < 2; ++n) _Pragma("unroll") for (int k = 0; k < 2; ++k) \
        acc[ai][bj][m][n] = __builtin_amdgcn_mfma_f32_16x16x32_bf16(Bt[n][k], At[m][k], acc[ai][bj][m][n], 0, 0, 0); __builtin_amdgcn_s_setprio(0); } while (0)
#define PG8_WAIT_V(n) asm volatile("s_waitcnt vmcnt(" #n ")" ::: "memory")
#define PG8_WAIT_L(n) asm volatile("s_waitcnt lgkmcnt(" #n ")" ::: "memory")
#define PG8_BAR __builtin_amdgcn_s_barrier()
#define PG8_SCHED __builtin_amdgcn_sched_barrier(0)
    Unit cur, nxt, prv; int ui = 0; bool has_prv = false;
    if (!S.next(0, cur)) return;
    f32x4 acc[2][2][4][2];
#pragma unroll
    for (int a = 0; a < 2; ++a)
#pragma unroll
        for (int b = 0; b < 2; ++b)
#pragma unroll
            for (int m = 0; m < 4; ++m)
#pragma unroll
                for (int n = 0; n < 2; ++n) acc[a][b][m][n] = (f32x4){0.f, 0.f, 0.f, 0.f};
    bf16x8 At[4][2], B0[2][2], B1[2][2];
    const char* cA = (const char*)g.A + (size_t)cur.pm * tstepA; const char* cB = (const char*)g.Bt + (size_t)cur.pn * tstepB;
    S.a_ready(cur);
    if constexpr (SP2) {
        PG8_STAGE(PG8_SB(0, 0), cB, voffB); PG8_STAGE(PG8_SB(0, 1), cB + hstepB, voffB); PG8_STAGE(PG8_SA(0, 0), cA, voffA); PG8_STAGE(PG8_SA(0, 1), cA + hstepA, voffA);
        if (wr == 1) PG8_BAR;
        PG8_WAIT_V(2); PG8_BAR;
        PG8_STAGE(PG8_SB(1, 0), cB + kstep, voffB); PG8_STAGE(PG8_SA(1, 0), cA + kstep, voffA); PG8_STAGE(PG8_SB(1, 1), cB + hstepB + kstep, voffB);
        PG8_WAIT_V(6); PG8_BAR;
    } else {
        PG8_STAGE(PG8_SB(0, 0), cB, voffB); PG8_STAGE(PG8_SA(0, 0), cA, voffA); PG8_STAGE(PG8_SB(0, 1), cB + hstepB, voffB); PG8_STAGE(PG8_SA(0, 1), cA + hstepA, voffA);
        if (wr == 1) PG8_BAR;
        PG8_WAIT_V(4); PG8_BAR;
        PG8_STAGE(PG8_SB(1, 0), cB + kstep, voffB); PG8_STAGE(PG8_SA(1, 0), cA + kstep, voffA); PG8_STAGE(PG8_SB(1, 1), cB + hstepB + kstep, voffB);
        PG8_WAIT_V(6); PG8_BAR;
    }
    for (;;) {
        const bool has_next = S.next(ui + 1, nxt);
        const char* nA = has_next ? (const char*)g.A + (size_t)nxt.pm * tstepA : cA; const char* nB = has_next ? (const char*)g.Bt + (size_t)nxt.pn * tstepB : cB;
        for (int t = 0; t < nt; t += 2) {
            const bool last = (t == nt - 2);
            const char* a1 = cA + (size_t)(t + 1) * kstep;
            const char* a2 = last ? nA : cA + (size_t)(t + 2) * kstep; const char* b2 = last ? nB : cB + (size_t)(t + 2) * kstep;
            const char* a3 = a2 + kstep; const char* b3 = b2 + kstep;
            if (last && has_next) S.a_ready(nxt);
            if constexpr (SP2) {
            PG8_LDB(B0, 0, 0); PG8_LDB(B1, 0, 1); PG8_SCHED; PG8_LDA(At, 0, 0); PG8_STAGE(PG8_SA(1, 1), a1 + hstepA, voffA);
            PG8_WAIT_V(8); PG8_WAIT_L(0); PG8_BAR; PG8_MMA(0, 0, At, B0); PG8_MMA(0, 1, At, B1); PG8_BAR; PG8_SCHED;
            PG8_LDA(At, 0, 1); PG8_STAGE(PG8_SB(0, 0), b2, voffB); PG8_STAGE(PG8_SB(0, 1), b2 + hstepB, voffB); PG8_STAGE(PG8_SA(0, 0), a2, voffA);
            PG8_WAIT_V(8); PG8_WAIT_L(0); PG8_BAR; PG8_MMA(1, 0, At, B0); PG8_MMA(1, 1, At, B1); PG8_BAR; PG8_SCHED;
            PG8_LDB(B0, 1, 0); PG8_LDB(B1, 1, 1); PG8_SCHED; PG8_LDA(At, 1, 0); PG8_STAGE(PG8_SA(0, 1), a2 + hstepA, voffA);
            PG8_WAIT_V(8); PG8_WAIT_L(0); PG8_BAR; PG8_MMA(0, 0, At, B0); PG8_MMA(0, 1, At, B1); PG8_BAR; PG8_SCHED;
            PG8_LDA(At, 1, 1); PG8_STAGE(PG8_SB(1, 0), b3, voffB); PG8_STAGE(PG8_SB(1, 1), b3 + hstepB, voffB); PG8_STAGE(PG8_SA(1, 0), a3, voffA);
            PG8_WAIT_V(8); PG8_WAIT_L(0); PG8_BAR; PG8_MMA(1, 0, At, B0); PG8_MMA(1, 1, At, B1); PG8_BAR; PG8_SCHED;
            } else {
            PG8_LDB(B0, 0, 0); PG8_SCHED; PG8_LDA(At, 0, 0); PG8_STAGE(PG8_SA(1, 1), a1 + hstepA, voffA);
            PG8_WAIT_L(8); PG8_BAR; PG8_WAIT_L(0); PG8_MMA(0, 0, At, B0); PG8_BAR; PG8_SCHED;
            PG8_LDB(B1, 0, 1); PG8_STAGE(PG8_SB(0, 0), b2, voffB);
            PG8_BAR; PG8_WAIT_L(0); PG8_MMA(0, 1, At, B1); PG8_BAR;
            PG8_LDA(At, 0, 1); PG8_STAGE(PG8_SA(0, 0), a2, voffA);
            PG8_BAR; PG8_WAIT_L(0); PG8_MMA(1, 0, At, B0); PG8_BAR; PG8_SCHED;
            PG8_STAGE(PG8_SB(0, 1), b2 + hstepB, voffB);
            PG8_WAIT_V(6); PG8_BAR; PG8_MMA(1, 1, At, B1); PG8_BAR;
            PG8_LDB(B0, 1, 0); PG8_SCHED; PG8_LDA(At, 1, 0); PG8_STAGE(PG8_SA(0, 1), a2 + hstepA, voffA);
            PG8_WAIT_L(8); PG8_BAR; PG8_WAIT_L(0); PG8_MMA(0, 0, At, B0); PG8_BAR; PG8_SCHED;
            PG8_LDB(B1, 1, 1); PG8_STAGE(PG8_SB(1, 0), b3, voffB);
            PG8_BAR; PG8_WAIT_L(0); PG8_MMA(0, 1, At, B1); PG8_BAR;
            PG8_LDA(At, 1, 1); PG8_STAGE(PG8_SA(1, 0), a3, voffA);
            PG8_BAR; PG8_WAIT_L(0); PG8_MMA(1, 0, At, B0); PG8_BAR; PG8_SCHED;
            PG8_STAGE(PG8_SB(1, 1), b3 + hstepB, voffB);
            PG8_WAIT_V(6); PG8_BAR; PG8_MMA(1, 1, At, B1); PG8_BAR;
            }
        }
        if constexpr (ALIGN_EPI) { if (wr == 0) PG8_BAR; }
        if constexpr (!Epi::AFTER_DRAIN) { E(acc, cur, wr, wc, fr, fq); S.done(cur); }
        if constexpr (Epi::DEFER) { if (has_prv) E.deferred(prv); prv = cur; has_prv = true; }
        if (!has_next) break;
#pragma unroll
        for (int a = 0; a < 2; ++a)
#pragma unroll
            for (int b = 0; b < 2; ++b)
#pragma unroll
                for (int m = 0; m < 4; ++m)
#pragma unroll
                    for (int n = 0; n < 2; ++n) acc[a][b][m][n] = (f32x4){0.f, 0.f, 0.f, 0.f};
        cur = nxt; cA = nA; cB = nB; ++ui;
        if constexpr (ALIGN_EPI) { if (wr == 1) PG8_BAR; }
    }
    PG8_WAIT_V(0);
    if constexpr (!ALIGN_EPI) { if (wr == 0) PG8_BAR; }
    PG8_BAR;
    if constexpr (Epi::AFTER_DRAIN) { E.fused(acc, cur, wr, wc, fr, fq, lds, wid, lane); S.done(cur); }
    if constexpr (Epi::DEFER) { if (has_prv) E.deferred(prv); }
#undef PG8_SA
#undef PG8_SB
#undef PG8_STAGE
#undef PG8_LDA
#undef PG8_LDB
#undef PG8_MMA
#undef PG8_WAIT_V
#undef PG8_WAIT_L
#undef PG8_BAR
#undef PG8_SCHED
}
}

struct EpiStore {
    static constexpr bool PERM = true, AFTER_DRAIN = false, DEFER = false;
    bf16_t* O; int ldc;
    DI void operator()(const f32x4 (&acc)[2][2][4][2], const pg8::Unit& u, int wr, int wc, int fr, int fq) const {
        const int row0 = u.pm * 256 + wr * 64 + fr, col0 = u.pn * 256 + wc * 32 + 8 * fq;
#pragma unroll
        for (int ai = 0; ai < 2; ++ai)
#pragma unroll
            for (int m = 0; m < 4; ++m) { bf16_t* rowp = O + (size_t)(row0 + ai * 128 + m * 16) * ldc + col0;
#pragma unroll
                for (int bj = 0; bj < 2; ++bj) { const f32x4 v0 = acc[ai][bj][m][0], v1 = acc[ai][bj][m][1];
                    u32x4 w; w.x = pk2(v0[0], v0[1]); w.y = pk2(v0[2], v0[3]); w.z = pk2(v1[0], v1[1]); w.w = pk2(v1[2], v1[3]);
                    *(u32x4*)(rowp + bj * 128) = w; } }
    }
};
struct EpiProj {
    static constexpr bool PERM = true, AFTER_DRAIN = false, DEFER = false;
    bf16_t* proj; bf16_t* gates;
    DI void operator()(const f32x4 (&acc)[2][2][4][2], const pg8::Unit& u, int wr, int wc, int fr, int fq) const {
        const bool isg = u.pn >= NPROJ_TILES;
        bf16_t* base = isg ? gates : proj; const int ldc = isg ? 2048 : LDP; const int colt = isg ? (u.pn - NPROJ_TILES) * 256 : u.pn * 256;
        const int row0 = u.pm * 256 + wr * 64 + fr, col0 = colt + wc * 32 + 8 * fq;
#pragma unroll
        for (int ai = 0; ai < 2; ++ai)
#pragma unroll
            for (int m = 0; m < 4; ++m) { bf16_t* rowp = base + (size_t)(row0 + ai * 128 + m * 16) * ldc + col0;
#pragma unroll
                for (int bj = 0; bj < 2; ++bj) { f32x4 v0 = acc[ai][bj][m][0], v1 = acc[ai][bj][m][1];
                    if (isg) {
#pragma unroll
                        for (int j = 0; j < 4; ++j) { v0[j] = sigmoidf_(v0[j]); v1[j] = sigmoidf_(v1[j]); } }
                    u32x4 w; w.x = pk2(v0[0], v0[1]); w.y = pk2(v0[2], v0[3]); w.z = pk2(v1[0], v1[1]); w.w = pk2(v1[2], v1[3]);
                    *(u32x4*)(rowp + bj * 128) = w; } }
    }
};
struct EpiGate {
    static constexpr bool PERM = true, AFTER_DRAIN = false, DEFER = false;
    bf16_t* G; int second;
    DI void operator()(const f32x4 (&acc)[2][2][4][2], const pg8::Unit& u, int wr, int wc, int fr, int fq) const {
        const int row0 = u.pm * 256 + wr * 64 + fr, col0 = u.pn * 256 + wc * 32 + 8 * fq;
#pragma unroll
        for (int ai = 0; ai < 2; ++ai) {
            u32x4 gv[4][2], pv[4][2];
#pragma unroll
            for (int m = 0; m < 4; ++m) { const bf16_t* rowp = G + (size_t)(row0 + ai * 128 + m * 16) * 2048 + col0;
#pragma unroll
                for (int bj = 0; bj < 2; ++bj) { gv[m][bj] = *(const u32x4*)(rowp + bj * 128 + (second ? 1024 : 0)); if (second) pv[m][bj] = *(const u32x4*)(rowp + bj * 128); } }
            asm volatile("" ::: "memory");
#pragma unroll
            for (int m = 0; m < 4; ++m) { bf16_t* rowp = G + (size_t)(row0 + ai * 128 + m * 16) * 2048 + col0;
#pragma unroll
                for (int bj = 0; bj < 2; ++bj) { const f32x4 v0 = acc[ai][bj][m][0], v1 = acc[ai][bj][m][1];
                    const u32x4 g = gv[m][bj];
                    float r[8];
                    r[0] = bf_lo(g.x) * v0[0]; r[1] = bf_hi(g.x) * v0[1]; r[2] = bf_lo(g.y) * v0[2]; r[3] = bf_hi(g.y) * v0[3];
                    r[4] = bf_lo(g.z) * v1[0]; r[5] = bf_hi(g.z) * v1[1]; r[6] = bf_lo(g.w) * v1[2]; r[7] = bf_hi(g.w) * v1[3];
                    if (second) { const u32x4 p = pv[m][bj];
                        r[0] += bf_lo(p.x); r[1] += bf_hi(p.x); r[2] += bf_lo(p.y); r[3] += bf_hi(p.y); r[4] += bf_lo(p.z); r[5] += bf_hi(p.z); r[6] += bf_lo(p.w); r[7] += bf_hi(p.w); }
                    u32x4 w; w.x = pk2(r[0], r[1]); w.y = pk2(r[2], r[3]); w.z = pk2(r[4], r[5]); w.w = pk2(r[6], r[7]);
                    *(u32x4*)(rowp + bj * 128) = w; } }
            asm volatile("" ::: "memory");
        }
    }
};
struct EpiSwiglu {
    static constexpr bool PERM = true, AFTER_DRAIN = false, DEFER = false;
    bf16_t* O;
    DI void operator()(const f32x4 (&acc)[2][2][4][2], const pg8::Unit& u, int wr, int wc, int fr, int fq) const {
        const int row0 = u.pm * 256 + wr * 64 + fr, col0 = u.pn * 128 + wc * 32 + 8 * fq;
#pragma unroll
        for (int ai = 0; ai < 2; ++ai)
#pragma unroll
            for (int m = 0; m < 4; ++m) { bf16_t* rowp = O + (size_t)(row0 + ai * 128 + m * 16) * DFF + col0;
                float r[8];
#pragma unroll
                for (int n = 0; n < 2; ++n)
#pragma unroll
                    for (int j = 0; j < 4; ++j) { const float g = acc[ai][0][m][n][j], uu = acc[ai][1][m][n][j]; r[4 * n + j] = g * sigmoidf_(g) * uu; }
                u32x4 w; w.x = pk2(r[0], r[1]); w.y = pk2(r[2], r[3]); w.z = pk2(r[4], r[5]); w.w = pk2(r[6], r[7]);
                *(u32x4*)rowp = w; }
    }
};

namespace att {
using s16x4 = __attribute__((ext_vector_type(4))) short;
constexpr int D = 128, NW = 8, QBLK = 32, KVBLK = 64;
constexpr float SCALE = 0.088388347648318440f;
constexpr float THR = 8.f;
constexpr int SHM_V = KVBLK * D * 2, SHM_K = KVBLK * D * 2, SHM_ATTN = 2 * SHM_V + 2 * SHM_K + NW * 64 * 4;
#define KSWZ(row, colB) ((row) * 256 + ((colB) ^ (((row) & 7) << 4)))
#define SBAR() __builtin_amdgcn_sched_barrier(0)
DI unsigned cvtpk(float lo, float hi) { unsigned r; asm volatile("v_cvt_pk_bf16_f32 %0, %1, %2" : "=v"(r) : "v"(lo), "v"(hi)); return r; }
DI void partialSM(f32x16& p0, f32x16& p1, float& m_reg, float& mn, float& alpha) {
  constexpr float C = SCALE * 1.4426950408889634f;
  float pmax = p0[0]; for (int r = 1; r < 16; ++r) pmax = fmaxf(pmax, p0[r]); for (int r = 0; r < 16; ++r) pmax = fmaxf(pmax, p1[r]);
  { auto rr = __builtin_amdgcn_permlane32_swap(__float_as_uint(pmax), __float_as_uint(pmax), false, false);
    pmax = fmaxf(__uint_as_float(rr[0]), __uint_as_float(rr[1])); }
  if (__builtin_expect(__all(pmax - m_reg <= THR / SCALE), 1)) { mn = m_reg; alpha = 1.f; }
  else { mn = fmaxf(m_reg, pmax); alpha = __builtin_amdgcn_exp2f((m_reg - mn) * C); m_reg = mn; }
  float mnC = -mn * C;
  for (int r = 0; r < 16; ++r) p0[r] = fmaf(p0[r], C, mnC); for (int r = 0; r < 16; ++r) p1[r] = fmaf(p1[r], C, mnC);
  for (int r = 0; r < 16; ++r) p0[r] = __builtin_amdgcn_exp2f(p0[r]);
}
DI void finishSM(f32x16& p0, f32x16& p1, float alpha, float& l_reg, bf16x8& pa0, bf16x8& pa1, bf16x8& pa2, bf16x8& pa3) {
  for (int r = 0; r < 16; ++r) p1[r] = __builtin_amdgcn_exp2f(p1[r]);
  float ps = 0; for (int r = 0; r < 16; ++r) ps += p0[r]; for (int r = 0; r < 16; ++r) ps += p1[r];
  { auto rr = __builtin_amdgcn_permlane32_swap(__float_as_uint(ps), __float_as_uint(ps), false, false);
    ps = __uint_as_float(rr[0]) + __uint_as_float(rr[1]); }
  l_reg = l_reg * alpha + ps;
#define PK4(P, BASE, OUT) do { unsigned a0 = cvtpk(P[BASE + 0], P[BASE + 1]), a1 = cvtpk(P[BASE + 2], P[BASE + 3]);   \
    unsigned b0 = cvtpk(P[BASE + 4], P[BASE + 5]), b1 = cvtpk(P[BASE + 6], P[BASE + 7]);                              \
    auto r0 = __builtin_amdgcn_permlane32_swap(a0, b0, false, false); auto r1 = __builtin_amdgcn_permlane32_swap(a1, b1, false, false); \
    u32x4 w = {r0[0], r1[0], r0[1], r1[1]}; OUT = *reinterpret_cast<bf16x8*>(&w); } while (0)
  PK4(p0, 0, pa0); PK4(p0, 8, pa1); PK4(p1, 0, pa2); PK4(p1, 8, pa3);
#undef PK4
}
DI void qkt(f32x16& p0, f32x16& p1, const LAS char* Ks, const bf16x8* qr, int r32, int hi) {
  p0 = f32x16{}; p1 = f32x16{};
  for (int d0 = 0; d0 < 8; ++d0) { int cb = (d0 * 16 + hi * 8) * 2;
    bf16x8 b0 = *reinterpret_cast<const LAS bf16x8*>(Ks + KSWZ(r32, cb));
    bf16x8 b1 = *reinterpret_cast<const LAS bf16x8*>(Ks + KSWZ(32 + r32, cb));
    p0 = MFMA32(b0, qr[d0], p0);
    p1 = MFMA32(b1, qr[d0], p1); }
}
DI int v_st(int k, int c) { const int kk = (k & ~0xC) | ((k & 4) << 1) | ((k & 8) >> 1); return ((kk >> 3) * 4 + (c >> 5)) * 512 + ((kk & 7) * 32 + (c & 31)) * 2; }
DI int v_rd_base(int lane) { return ((lane & 3) << 3) | (((lane >> 2) & 3) << 6) | (((lane >> 4) & 1) << 5) | (((lane >> 5) & 1) << 8); }
constexpr int v_rd_off(int d0, int ks, int half) { return d0 * 512 + ks * 4096 + half * 2048; }
template <int OFF> DI s16x4 tr_read(int vb) {
  s16x4 r; asm volatile("ds_read_b64_tr_b16 %0, %1 offset:%2" : "=&v"(r) : "v"(vb), "i"(OFF) : "memory"); return r;
}
template <int D0> DI void pv_one(f32x16& od, int vb, bf16x8 pa0, bf16x8 pa1, bf16x8 pa2, bf16x8 pa3) {
  const s16x4 l0 = tr_read<v_rd_off(D0, 0, 0)>(vb), h0 = tr_read<v_rd_off(D0, 0, 1)>(vb), l1 = tr_read<v_rd_off(D0, 1, 0)>(vb), h1 = tr_read<v_rd_off(D0, 1, 1)>(vb);
  const s16x4 l2 = tr_read<v_rd_off(D0, 2, 0)>(vb), h2 = tr_read<v_rd_off(D0, 2, 1)>(vb), l3 = tr_read<v_rd_off(D0, 3, 0)>(vb), h3 = tr_read<v_rd_off(D0, 3, 1)>(vb);
  asm volatile("s_waitcnt lgkmcnt(0)" ::: "memory"); SBAR();
#define PK(L, H) (bf16x8){L[0], L[1], L[2], L[3], H[0], H[1], H[2], H[3]}
  od = MFMA32(pa0, PK(l0, h0), od);
  od = MFMA32(pa1, PK(l1, h1), od);
  od = MFMA32(pa2, PK(l2, h2), od);
  od = MFMA32(pa3, PK(l3, h3), od);
#undef PK
}
DI void pv_d0(f32x16* o, int vb, bf16x8 pa0, bf16x8 pa1, bf16x8 pa2, bf16x8 pa3) {
  pv_one<0>(o[0], vb, pa0, pa1, pa2, pa3); pv_one<1>(o[1], vb, pa0, pa1, pa2, pa3); pv_one<2>(o[2], vb, pa0, pa1, pa2, pa3); pv_one<3>(o[3], vb, pa0, pa1, pa2, pa3);
}
template <int LDQ, int LDK, int LDO>
DI void attn_dense_body(const bf16_t* __restrict__ Qb, const bf16_t* __restrict__ Kh, const bf16_t* __restrict__ Vh, bf16_t* __restrict__ Ob, int seq, LAS char* lds,
                        const float* __restrict__ qn, const float* __restrict__ tab, int tq0) {
  const int tid = tid_opaque(), wid = tid >> 6, lane = tid & 63, r32 = lane & 31, hi = lane >> 5;
  LAS char* V_lds = lds; LAS char* K_lds = lds + 2 * SHM_V;
  LAS float* ws = (LAS float*)(lds + 2 * SHM_V + 2 * SHM_K) + wid * 64; LAS float* li_l = ws; LAS float* al_l = ws + 32;
  float m_reg = -1e30f, l_reg = 0; f32x16 o[4] = {}; bf16x8 qr[8];
  const bf16_t* Qw = Qb + (long)(wid * QBLK + r32) * LDQ + hi * 8;
  {
    u32x4 raw[8];
#pragma unroll
    for (int d0 = 0; d0 < 8; ++d0) raw[d0] = *reinterpret_cast<const u32x4*>(Qw + d0 * 16);
    float ss = 0.f;
#pragma unroll
    for (int d0 = 0; d0 < 8; ++d0) { const float a0 = bf_lo(raw[d0].x), a1 = bf_hi(raw[d0].x), a2 = bf_lo(raw[d0].y), a3 = bf_hi(raw[d0].y), a4 = bf_lo(raw[d0].z), a5 = bf_hi(raw[d0].z), a6 = bf_lo(raw[d0].w), a7 = bf_hi(raw[d0].w);
      ss += ((a0 * a0 + a1 * a1) + (a2 * a2 + a3 * a3)) + ((a4 * a4 + a5 * a5) + (a6 * a6 + a7 * a7)); }
    ss += __shfl_xor(ss, 32);
    const float rstd = rsqrtf(ss * (1.f / 128.f) + 1e-6f);
    const int tq = tq0 + wid * QBLK + r32;
#pragma unroll
    for (int blk = 0; blk < 2; ++blk) {
      const int pos = blk ? (tq & 63) : (tq >> 6);
#pragma unroll
      for (int dd = 0; dd < 2; ++dd) {
        const int d0 = 4 * blk + dd, fb = dd * 16 + hi * 8;
        float x1[8], x2[8];
        x1[0] = bf_lo(raw[d0].x); x1[1] = bf_hi(raw[d0].x); x1[2] = bf_lo(raw[d0].y); x1[3] = bf_hi(raw[d0].y); x1[4] = bf_lo(raw[d0].z); x1[5] = bf_hi(raw[d0].z); x1[6] = bf_lo(raw[d0].w); x1[7] = bf_hi(raw[d0].w);
        x2[0] = bf_lo(raw[d0 + 2].x); x2[1] = bf_hi(raw[d0 + 2].x); x2[2] = bf_lo(raw[d0 + 2].y); x2[3] = bf_hi(raw[d0 + 2].y); x2[4] = bf_lo(raw[d0 + 2].z); x2[5] = bf_hi(raw[d0 + 2].z); x2[6] = bf_lo(raw[d0 + 2].w); x2[7] = bf_hi(raw[d0 + 2].w);
        float o1[8], o2[8];
#pragma unroll
        for (int hx = 0; hx < 2; ++hx) {
          const f32x4 g1 = *(const f32x4*)(qn + d0 * 16 + hi * 8 + 4 * hx), g2 = *(const f32x4*)(qn + (d0 + 2) * 16 + hi * 8 + 4 * hx);
          const f32x4 cs = *(const f32x4*)(tab + pos * 32 + fb + 4 * hx), sn = *(const f32x4*)(tab + 2048 + pos * 32 + fb + 4 * hx);
#pragma unroll
          for (int x = 0; x < 4; ++x) { const float a = x1[4 * hx + x] * rstd * g1[x], b = x2[4 * hx + x] * rstd * g2[x];
            o1[4 * hx + x] = a * cs[x] - b * sn[x]; o2[4 * hx + x] = b * cs[x] + a * sn[x]; }
        }
        u32x4 w1, w2;
        w1.x = pk2(o1[0], o1[1]); w1.y = pk2(o1[2], o1[3]); w1.z = pk2(o1[4], o1[5]); w1.w = pk2(o1[6], o1[7]);
        w2.x = pk2(o2[0], o2[1]); w2.y = pk2(o2[2], o2[3]); w2.z = pk2(o2[4], o2[5]); w2.w = pk2(o2[6], o2[7]);
        qr[d0] = __builtin_bit_cast(bf16x8, w1); qr[d0 + 2] = __builtin_bit_cast(bf16x8, w2);
      }
    }
  }
  const int sr = tid >> 4, sc = (tid & 15) * 8, vst0 = v_st(sr, sc), vst1 = v_st(32 + sr, sc);
  const int vb0 = (int)(uintptr_t)V_lds + v_rd_base(lane);
  struct { bf16x8 vs0, vs1, ks0, ks1; } sr_[2];
#define SLOAD(i, k0) do { sr_[i].vs0 = *reinterpret_cast<const bf16x8*>(&Vh[(long)((k0) + sr) * LDK + sc]); sr_[i].vs1 = *reinterpret_cast<const bf16x8*>(&Vh[(long)((k0) + 32 + sr) * LDK + sc]); \
    sr_[i].ks0 = *reinterpret_cast<const bf16x8*>(&Kh[(long)((k0) + sr) * LDK + sc]); sr_[i].ks1 = *reinterpret_cast<const bf16x8*>(&Kh[(long)((k0) + 32 + sr) * LDK + sc]); } while (0)
#define SWRITE(b, i) do { *(LAS bf16x8*)(V_lds + (b) * SHM_V + vst0) = sr_[i].vs0;          \
    *(LAS bf16x8*)(V_lds + (b) * SHM_V + vst1) = sr_[i].vs1; int kc = sc * 2;               \
    *(LAS bf16x8*)(K_lds + (b) * SHM_K + KSWZ(sr, kc)) = sr_[i].ks0;                       \
    *(LAS bf16x8*)(K_lds + (b) * SHM_K + KSWZ(32 + sr, kc)) = sr_[i].ks1; } while (0)
#define SWAIT() asm volatile("s_waitcnt vmcnt(4)" ::: "memory")
#define RESC(a) do { if (__any((a) < 1.f)) { if (hi == 0) al_l[r32] = (a); asm volatile("s_waitcnt lgkmcnt(0)" ::: "memory"); \
    for (int d = 0; d < 4; ++d) for (int r = 0; r < 16; ++r) o[d][r] *= al_l[crow(r, hi)]; } } while (0)
  f32x16 pA0, pA1, pB0, pB1; float mnA, mnB, alA, alB; bf16x8 pa0, pa1, pa2, pa3; const int NT = seq / KVBLK;
  constexpr int SE = 0, SO = 1;
  SLOAD(SE, 0); asm volatile("s_waitcnt vmcnt(0)" ::: "memory"); SWRITE(0, SE); __syncthreads();
  qkt(pA0, pA1, K_lds, qr, r32, hi); partialSM(pA0, pA1, m_reg, mnA, alA);
  SLOAD(SO, KVBLK); if (2 < NT) SLOAD(SE, 2 * KVBLK);
  SWAIT(); SWRITE(1, SO); __syncthreads();
  for (int j = 1; j + 1 < NT; j += 2) {
    SBAR(); qkt(pB0, pB1, K_lds + SHM_K, qr, r32, hi);
    finishSM(pA0, pA1, alA, l_reg, pa0, pa1, pa2, pa3); SBAR();
    SLOAD(SO, (j + 2) * KVBLK); SBAR();
    pv_d0(o, vb0, pa0, pa1, pa2, pa3); partialSM(pB0, pB1, m_reg, mnB, alB);
    __syncthreads(); SWAIT(); SWRITE(0, SE);
    RESC(alB); __syncthreads();
    SBAR(); qkt(pA0, pA1, K_lds, qr, r32, hi);
    finishSM(pB0, pB1, alB, l_reg, pa0, pa1, pa2, pa3); SBAR();
    if (j + 3 < NT) SLOAD(SE, (j + 3) * KVBLK); SBAR();
    pv_d0(o, vb0 + (int)SHM_V, pa0, pa1, pa2, pa3); partialSM(pA0, pA1, m_reg, mnA, alA);
    __syncthreads(); SWAIT(); SWRITE(1, SO);
    RESC(alA); __syncthreads();
  }
  SBAR(); qkt(pB0, pB1, K_lds + SHM_K, qr, r32, hi);
  finishSM(pA0, pA1, alA, l_reg, pa0, pa1, pa2, pa3); SBAR();
  pv_d0(o, vb0, pa0, pa1, pa2, pa3); partialSM(pB0, pB1, m_reg, mnB, alB);
  __syncthreads(); RESC(alB);
  finishSM(pB0, pB1, alB, l_reg, pa0, pa1, pa2, pa3); SBAR();
  pv_d0(o, vb0 + (int)SHM_V, pa0, pa1, pa2, pa3);
  if (hi == 0) li_l[r32] = l_reg; asm volatile("s_waitcnt lgkmcnt(0)" ::: "memory");
  float rli[16];
#pragma unroll
  for (int r = 0; r < 16; ++r) rli[r] = __builtin_amdgcn_rcpf(li_l[crow(r, hi)]);
  bf16_t* Ow = Ob + (long)(wid * QBLK) * LDO;
#pragma unroll
  for (int r = 0; r < 16; ++r) { int orow = crow(r, hi);
#pragma unroll
    for (int d0 = 0; d0 < 4; ++d0) Ow[(long)orow * LDO + d0 * 32 + r32] = f2bf(o[d0][r] * rli[r]); }
  __syncthreads();
#undef SLOAD
#undef SWRITE
#undef SWAIT
#undef RESC
}
}

namespace gla {
constexpr int QG_OFF = 0, KG_OFF = 17408, KGT_OFF = 34816, VT_OFF = 53248, PM_OFF = 90112, DEC_OFF = 99328, ZB_OFF = 99840, GB_OFF = 101888;
constexpr float QSCALE = 0.08838834764831845f;
DI void item(LAS char* lds, const bf16_t* __restrict__ proj, const bf16_t* __restrict__ gvt, bf16_t* __restrict__ ofb,
             const float* __restrict__ wa, const float* __restrict__ ba, int bl, int h, int dir) {
    const int tid = tid_opaque(), wid = tid >> 6, lane = tid & 63, r32 = lane & 31, hi = lane >> 5;
    const int d = tid & 127, part = tid >> 7;
    LAS char* QG = lds + QG_OFF; LAS char* KG = lds + KG_OFF; LAS char* KGT = lds + KGT_OFF; LAS char* VT = lds + VT_OFF; LAS char* PM = lds + PM_OFF;
    LAS float* DEC = (LAS float*)(lds + DEC_OFF); LAS char* ZB = lds + ZB_OFF; LAS char* GB = lds + GB_OFF;
    const int xib = wid & 1, xdb = wid >> 1;
    bf16x8 wfrag; float bav;
    { const float* wp = wa + (size_t)(8 * hi) * 512 + h * 128 + 32 * xdb + r32;
      u32x4 w; w.x = pk2(wp[0], wp[512]); w.y = pk2(wp[1024], wp[1536]); w.z = pk2(wp[2048], wp[2560]); w.w = pk2(wp[3072], wp[3584]);
      wfrag = __builtin_bit_cast(bf16x8, w); bav = ba[h * 128 + 32 * xdb + r32]; }
    f32x16 S[4];
#pragma unroll
    for (int i = 0; i < 4; ++i) S[i] = f32x16{};
    const int tb = bl * T;
    const int ew = 32 * wid;
    const int qrow = tid >> 4, qseg = tid & 15;
    const int zrow = (tid & 127) >> 1, zseg = tid & 1;
    const int ve = tid >> 3, vseg = tid & 7;
    u32x4 pq[2], pkk[2], pz, pv[4];
#define GLA_LOAD(cc) do { const int t0_ = tb + (cc) * 64; const bf16_t* cb_ = proj + (size_t)t0_ * LDP; \
        _Pragma("unroll") for (int x = 0; x < 2; ++x) { pq[x] = *(const u32x4*)(cb_ + (size_t)(qrow + 32 * x) * LDP + PC_GQ + h * 128 + qseg * 8); \
            pkk[x] = *(const u32x4*)(cb_ + (size_t)(qrow + 32 * x) * LDP + PC_GK + h * 128 + qseg * 8); } \
        pz = *(const u32x4*)(cb_ + (size_t)zrow * LDP + PC_Z + dir * 16 + zseg * 8); \
        _Pragma("unroll") for (int x = 0; x < 4; ++x) pv[x] = *(const u32x4*)(gvt + (size_t)(h * 256 + ve + 64 * x) * MR + t0_ + vseg * 8); } while (0)
    GLA_LOAD(dir ? 31 : 0);
    for (int n = 0; n < 32; ++n) {
        const int c = dir ? 31 - n : n; const int t0 = tb + c * 64;
        __syncthreads();
#pragma unroll
        for (int x = 0; x < 2; ++x) { *(LAS u32x4*)(QG + (qrow + 32 * x) * 272 + qseg * 16) = pq[x]; *(LAS u32x4*)(KG + (qrow + 32 * x) * 272 + qseg * 16) = pkk[x]; }
        if (tid < 128) *(LAS u32x4*)(ZB + zrow * 32 + zseg * 16) = pz;
#pragma unroll
        for (int x = 0; x < 4; ++x) *(LAS u32x4*)(VT + (ve + 64 * x) * 144 + vseg * 16) = pv[x];
        if (n + 1 < 32) GLA_LOAD(dir ? 30 - n : n + 1);
        __syncthreads();
        {
            const bf16x8 za = *(const LAS bf16x8*)(ZB + (32 * xib + r32) * 32 + hi * 16);
            const f32x16 xa = MFMA32(za, wfrag, f32x16{});
#pragma unroll
            for (int g = 0; g < 4; ++g) { f32x4 gv;
#pragma unroll
                for (int x = 0; x < 4; ++x) { const float xv = xa[4 * g + x] + bav; gv[x] = (fminf(xv, 0.f) - __logf(1.f + __expf(-fabsf(xv)))) * (1.f / 16.f); }
                *(LAS f32x4*)(GB + (32 * xdb + r32) * 272 + (32 * xib + 8 * g + 4 * hi) * 4) = gv; }
        }
        __syncthreads();
        int d = tid & 127, part = tid >> 7; asm volatile("" : "+v"(d), "+v"(part));
        float bc[16]; float tot;
        {
            float ps[4];
#pragma unroll
            for (int p = 0; p < 4; ++p) { float a = 0.f;
#pragma unroll
                for (int q = 0; q < 4; ++q) { const f32x4 v = *(const LAS f32x4*)(GB + d * 272 + p * 64 + q * 16); a += (v[0] + v[1]) + (v[2] + v[3]);
                    if (p == part) { bc[4 * q] = v[0]; bc[4 * q + 1] = v[1]; bc[4 * q + 2] = v[2]; bc[4 * q + 3] = v[3]; } }
                ps[p] = a; }
            tot = (ps[0] + ps[1]) + (ps[2] + ps[3]);
            float off;
            if (dir == 0) off = (part > 0 ? ps[0] : 0.f) + (part > 1 ? ps[1] : 0.f) + (part > 2 ? ps[2] : 0.f);
            else off = (part < 3 ? ps[3] : 0.f) + (part < 2 ? ps[2] : 0.f) + (part < 1 ? ps[1] : 0.f);
            if (dir == 0) { bc[0] += off;
#pragma unroll
                for (int rr = 1; rr < 16; ++rr) bc[rr] += bc[rr - 1];
            } else { bc[15] += off;
#pragma unroll
                for (int rr = 14; rr >= 0; --rr) bc[rr] += bc[rr + 1];
            }
        }
        if (part == 0) DEC[d] = __expf(tot);
        unsigned kpk[8];
#pragma unroll
        for (int rr = 0; rr < 16; rr += 2) {
            float kv2[2];
#pragma unroll
            for (int x = 0; x < 2; ++x) {
                const int i = part * 16 + rr + x;
                LAS bf16_t* qp = (LAS bf16_t*)(QG + i * 272 + d * 2); LAS bf16_t* kp = (LAS bf16_t*)(KG + i * 272 + d * 2);
                const float eb = __expf(bc[rr + x]);
                const float qv = bf2f(*qp) * QSCALE * eb;
                const float kv = bf2f(*kp) * __builtin_amdgcn_rcpf(eb);
                *qp = f2bf(qv); *kp = f2bf(kv);
                kv2[x] = kv;
            }
            kpk[rr >> 1] = pk2(kv2[0], kv2[1]);
        }
        {
            u32x4 w0, w1;
            w0.x = kpk[0]; w0.y = kpk[1]; w0.z = kpk[2]; w0.w = kpk[3]; w1.x = kpk[4]; w1.y = kpk[5]; w1.z = kpk[6]; w1.w = kpk[7];
            *(LAS u32x4*)(KGT + d * 144 + part * 32) = w0; *(LAS u32x4*)(KGT + d * 144 + part * 32 + 16) = w1;
        }
        __syncthreads();
        if (wid < 4) {
            int r32 = lane & 31, hi = lane >> 5; asm volatile("" : "+v"(r32), "+v"(hi));
            const int jb = wid >> 1, ib = wid & 1;
            f32x16 acc = f32x16{};
#pragma unroll
            for (int s = 0; s < 8; ++s) {
                const bf16x8 a = *(const LAS bf16x8*)(KG + (32 * jb + r32) * 272 + (16 * s + 8 * hi) * 2);
                const bf16x8 b = *(const LAS bf16x8*)(QG + (32 * ib + r32) * 272 + (16 * s + 8 * hi) * 2);
                acc = MFMA32(a, b, acc);
            }
            int i = 32 * ib + r32; asm volatile("" : "+v"(i));
#pragma unroll
            for (int g = 0; g < 4; ++g) { const int jbase = 32 * jb + 8 * g + 4 * hi; float v[4];
#pragma unroll
                for (int x = 0; x < 4; ++x) { const int j = jbase + x; const bool keep = dir ? (j > i) : (j <= i); v[x] = keep ? acc[4 * g + x] : 0.f; }
                u32x2 w; w.x = pk2(v[0], v[1]); w.y = pk2(v[2], v[3]);
                *(LAS u32x2*)(PM + i * 144 + jbase * 2) = w; }
        }
        __syncthreads();
        int r32 = lane & 31, hi = lane >> 5; asm volatile("" : "+v"(r32), "+v"(hi));
        f32x16 o[2]; o[0] = f32x16{}; o[1] = f32x16{};
#pragma unroll
        for (int db = 0; db < 4; ++db)
#pragma unroll
            for (int s = 0; s < 2; ++s) {
                u32x4 bw; bw.x = pk2(S[db][8 * s + 0], S[db][8 * s + 1]); bw.y = pk2(S[db][8 * s + 2], S[db][8 * s + 3]);
                bw.z = pk2(S[db][8 * s + 4], S[db][8 * s + 5]); bw.w = pk2(S[db][8 * s + 6], S[db][8 * s + 7]);
                const bf16x8 bfrag = __builtin_bit_cast(bf16x8, bw);
                const int d0 = 32 * db + 16 * s + 4 * hi;
#pragma unroll
                for (int ib = 0; ib < 2; ++ib) {
                    const u32x2 a0 = *(const LAS u32x2*)(QG + (32 * ib + r32) * 272 + d0 * 2), a1 = *(const LAS u32x2*)(QG + (32 * ib + r32) * 272 + (d0 + 8) * 2);
                    u32x4 aw; aw.x = a0.x; aw.y = a0.y; aw.z = a1.x; aw.w = a1.y;
                    o[ib] = MFMA32(__builtin_bit_cast(bf16x8, aw), bfrag, o[ib]);
                }
            }
        bf16x8 vb[4];
#pragma unroll
        for (int s = 0; s < 4; ++s) vb[s] = *(const LAS bf16x8*)(VT + (ew + r32) * 144 + (16 * s + 8 * hi) * 2);
#pragma unroll
        for (int s = 0; s < 4; ++s)
#pragma unroll
            for (int ib = 0; ib < 2; ++ib) { const bf16x8 a = *(const LAS bf16x8*)(PM + (32 * ib + r32) * 144 + (16 * s + 8 * hi) * 2); o[ib] = MFMA32(a, vb[s], o[ib]); }
        {
            LAS char* OS = lds + GB_OFF + wid * 5120;
#pragma unroll
            for (int ib = 0; ib < 2; ++ib)
#pragma unroll
                for (int r = 0; r < 16; ++r) *(LAS bf16_t*)(OS + (32 * ib + crow(r, hi)) * 80 + r32 * 2) = f2bf(o[ib][r]);
            asm volatile("s_waitcnt lgkmcnt(0)" ::: "memory");
#pragma unroll
            for (int x = 0; x < 4; ++x) { const int p = lane + 64 * x, row = p >> 2, seg = p & 3;
                const u32x4 v = *(const LAS u32x4*)(OS + row * 80 + seg * 16);
                *(u32x4*)(ofb + (size_t)(t0 + row) * 1024 + h * 256 + ew + seg * 8) = v; }
        }
#pragma unroll
        for (int db = 0; db < 4; ++db) {
#pragma unroll
            for (int s = 0; s < 4; ++s) { const bf16x8 a = *(const LAS bf16x8*)(KGT + (32 * db + r32) * 144 + (16 * s + 8 * hi) * 2); S[db] = MFMA32(a, vb[s], S[db]); }
#pragma unroll
            for (int g = 0; g < 4; ++g) { const f32x4 dc = *(const LAS f32x4*)(DEC + 32 * db + 8 * g + 4 * hi);
#pragma unroll
                for (int x = 0; x < 4; ++x) S[db][4 * g + x] *= dc[x]; }
        }
    }
    __syncthreads();
#undef GLA_LOAD
}
}

namespace xat {
constexpr int KS_OFF = 0, KS_STRIDE = 528, VS_OFF = 34816, VS_STRIDE = 144, L_OFF = 34816 + 36864;
DI void unit(LAS char* lds, const bf16_t* __restrict__ qx, const bf16_t* __restrict__ kmem, const bf16_t* __restrict__ vtmem, bf16_t* __restrict__ ox, int b, int hx, int qb) {
    const int tid = tid_opaque(), wid = tid >> 6, lane = tid & 63, r32 = lane & 31, hi = lane >> 5;
    LAS char* KS = lds + KS_OFF; LAS char* VS = lds + VS_OFF; LAS float* LL = (LAS float*)(lds + L_OFF) + wid * 32;
    const int m0 = b * T + qb * 256 + wid * 32;
    bf16x8 qf[16];
    { const bf16_t* qp = qx + (size_t)(m0 + r32) * 1024 + hx * 256 + hi * 8;
#pragma unroll
      for (int s = 0; s < 16; ++s) qf[s] = *(const bf16x8*)(qp + 16 * s); }
    f32x16 sc[8];
#pragma unroll
    for (int kt = 0; kt < 4; ++kt) {
#pragma unroll
        for (int x = 0; x < 4; ++x) { const int p = tid + 512 * x, key = p >> 5, seg = p & 31;
            const u32x4 v = *(const u32x4*)(kmem + (size_t)(b * NMEM + 64 * kt + key) * 1024 + hx * 256 + seg * 8);
            *(LAS u32x4*)(KS + key * KS_STRIDE + seg * 16) = v; }
        __syncthreads();
#pragma unroll
        for (int kb = 0; kb < 2; ++kb) { f32x16 acc = f32x16{};
#pragma unroll
            for (int s = 0; s < 16; ++s) { const bf16x8 a = *(const LAS bf16x8*)(KS + (32 * kb + r32) * KS_STRIDE + (16 * s + 8 * hi) * 2); acc = MFMA32(a, qf[s], acc); }
            sc[kt * 2 + kb] = acc; }
        __syncthreads();
    }
    float mx = sc[0][0];
#pragma unroll
    for (int t = 0; t < 8; ++t)
#pragma unroll
        for (int r = 0; r < 16; ++r) mx = fmaxf(mx, sc[t][r]);
    mx = fmaxf(mx, __shfl_xor(mx, 32));
    float sum = 0.f;
    u32x4 pp[8][2];
#pragma unroll
    for (int t = 0; t < 8; ++t) {
#pragma unroll
        for (int r = 0; r < 16; ++r) { const float e = __expf(sc[t][r] - mx); sum += e; sc[t][r] = e; }
#pragma unroll
        for (int s = 0; s < 2; ++s) { pp[t][s].x = pk2(sc[t][8 * s + 0], sc[t][8 * s + 1]); pp[t][s].y = pk2(sc[t][8 * s + 2], sc[t][8 * s + 3]);
            pp[t][s].z = pk2(sc[t][8 * s + 4], sc[t][8 * s + 5]); pp[t][s].w = pk2(sc[t][8 * s + 6], sc[t][8 * s + 7]); }
    }
    sum += __shfl_xor(sum, 32);
    if (hi == 0) LL[r32] = sum;
    f32x16 o[8];
#pragma unroll
    for (int eb = 0; eb < 8; ++eb) o[eb] = f32x16{};
#pragma unroll
    for (int kt = 0; kt < 4; ++kt) {
#pragma unroll
        for (int x = 0; x < 4; ++x) { const int p = tid + 512 * x, e = p >> 3, seg = p & 7;
            const u32x4 v = *(const u32x4*)(vtmem + (size_t)(hx * 256 + e) * MMEM + b * NMEM + 64 * kt + seg * 8);
            *(LAS u32x4*)(VS + e * VS_STRIDE + seg * 16) = v; }
        __syncthreads();
#pragma unroll
        for (int kb = 0; kb < 2; ++kb)
#pragma unroll
            for (int s = 0; s < 2; ++s) { const bf16x8 a = __builtin_bit_cast(bf16x8, pp[kt * 2 + kb][s]); const int k0 = 32 * kb + 16 * s + 4 * hi;
#pragma unroll
                for (int eb = 0; eb < 8; ++eb) {
                    const u32x2 b0 = *(const LAS u32x2*)(VS + (32 * eb + r32) * VS_STRIDE + k0 * 2), b1 = *(const LAS u32x2*)(VS + (32 * eb + r32) * VS_STRIDE + (k0 + 8) * 2);
                    u32x4 bw; bw.x = b0.x; bw.y = b0.y; bw.z = b1.x; bw.w = b1.y;
                    o[eb] = MFMA32(a, __builtin_bit_cast(bf16x8, bw), o[eb]); } }
        __syncthreads();
    }
    float rl[16];
#pragma unroll
    for (int r = 0; r < 16; ++r) rl[r] = __builtin_amdgcn_rcpf(LL[crow(r, hi)]);
#pragma unroll
    for (int r = 0; r < 16; ++r) { bf16_t* op = ox + (size_t)(m0 + crow(r, hi)) * 1024 + hx * 256 + r32;
#pragma unroll
        for (int eb = 0; eb < 8; ++eb) op[32 * eb] = f2bf(o[eb][r] * rl[r]); }
}
}

struct Args { const float* in[27]; float* out; unsigned char* ws; int ph_lo, ph_hi; };
enum { I_XP = 0, I_XS, I_MP, I_MS, I_LN_MIX_PRE, I_W_IN, I_WA_F, I_BA_F, I_WA_B, I_BA_B, I_GLA_NORM, I_QNORM, I_KNORM, I_W_BR_GLA, I_W_BR_ATT, I_W_OUT, I_LN_MIX_POST,
       I_LN_X_PRE, I_LN_MEM, I_X_WQ, I_X_WKV, I_X_WO, I_LN_X_POST, I_LN_FFN_PRE, I_FFN_WI, I_FFN_WO, I_LN_FFN_POST };

DI void transpose_seg(const float* __restrict__ W, int K, int ldw, int c0, int ncols, bf16_t* __restrict__ WT, int drow0, int mode, float sc, LAS float* scr, int gw, int NGW, int lane) {
    const int nblk = ncols / 32, nitems = (K / 64) * nblk;
    for (int it = gw; it < nitems; it += NGW) {
        const int kb = it / nblk, nb = it % nblk, k0 = 64 * kb, n0 = 32 * nb;
#pragma unroll 8
        for (int i = 0; i < 32; ++i) { const int kk = 2 * i + (lane >> 5); scr[kk * 33 + (lane & 31)] = W[(size_t)(k0 + kk) * ldw + c0 + n0 + (lane & 31)]; }
        asm volatile("s_waitcnt lgkmcnt(0)" ::: "memory");
        const int c = lane & 7;
#pragma unroll
        for (int j = 0; j < 4; ++j) { const int n = (lane >> 3) + 8 * j; const LAS float* s = scr + (8 * c) * 33 + n;
            u32x4 o; o.x = pk2(s[0 * 33] * sc, s[1 * 33] * sc); o.y = pk2(s[2 * 33] * sc, s[3 * 33] * sc); o.z = pk2(s[4 * 33] * sc, s[5 * 33] * sc); o.w = pk2(s[6 * 33] * sc, s[7 * 33] * sc);
            const int cs = n0 + n;
            int drow;
            if (mode == 1) { const int cc = c0 + cs; drow = cc < DFF ? (cc / 128) * 256 + (cc % 128) : ((cc - DFF) / 128) * 256 + 128 + ((cc - DFF) % 128); }
            else drow = drow0 + cs;
            *(u32x4*)(WT + (size_t)drow * K + k0 + 8 * c) = o; }
        asm volatile("s_waitcnt lgkmcnt(0)" ::: "memory");
    }
}
DI void rms_row_to_bf16(const float* __restrict__ xrow, const float* __restrict__ w, bf16_t* __restrict__ orow, int lane) {
    const f32x4* xr = (const f32x4*)xrow + lane; const f32x4* wr = (const f32x4*)w + lane;
    f32x4 v[4]; float s = 0.f;
#pragma unroll
    for (int j = 0; j < 4; ++j) { v[j] = xr[64 * j]; s += (v[j].x * v[j].x + v[j].y * v[j].y) + (v[j].z * v[j].z + v[j].w * v[j].w); }
    const float rstd = rsqrtf(wave_sum(s) * (1.f / 1024.f) + EPS);
    u32x2* o8 = (u32x2*)orow + lane;
#pragma unroll
    for (int j = 0; j < 4; ++j) { const f32x4 g = wr[64 * j]; u32x2 p; p.x = pk2(v[j].x * rstd * g.x, v[j].y * rstd * g.y); p.y = pk2(v[j].z * rstd * g.z, v[j].w * rstd * g.w); o8[64 * j] = p; }
}
DI void norm_res_row(const bf16_t* __restrict__ yrow, const float* __restrict__ base, const float* __restrict__ wpost, float* __restrict__ outrow,
                     const float* __restrict__ wpre, bf16_t* __restrict__ hrow, int lane) {
    const u32x2* yr = (const u32x2*)yrow + lane;
    f32x4 y[4]; float s = 0.f;
#pragma unroll
    for (int j = 0; j < 4; ++j) { const u32x2 p = yr[64 * j]; y[j].x = bf_lo(p.x); y[j].y = bf_hi(p.x); y[j].z = bf_lo(p.y); y[j].w = bf_hi(p.y);
        s += (y[j].x * y[j].x + y[j].y * y[j].y) + (y[j].z * y[j].z + y[j].w * y[j].w); }
    const float rstd = rsqrtf(wave_sum(s) * (1.f / 1024.f) + EPS);
    float s2 = 0.f;
#pragma unroll
    for (int j = 0; j < 4; ++j) { const f32x4 b = ((const f32x4*)base)[lane + 64 * j], g = ((const f32x4*)wpost)[lane + 64 * j];
        y[j] = b + y[j] * rstd * g; ((f32x4*)outrow)[lane + 64 * j] = y[j];
        s2 += (y[j].x * y[j].x + y[j].y * y[j].y) + (y[j].z * y[j].z + y[j].w * y[j].w); }
    if (hrow) {
        const float rstd2 = rsqrtf(wave_sum(s2) * (1.f / 1024.f) + EPS);
#pragma unroll
        for (int j = 0; j < 4; ++j) { const f32x4 g = ((const f32x4*)wpre)[lane + 64 * j]; u32x2 p; p.x = pk2(y[j].x * rstd2 * g.x, y[j].y * rstd2 * g.y); p.y = pk2(y[j].z * rstd2 * g.z, y[j].w * rstd2 * g.w);
            ((u32x2*)hrow)[lane + 64 * j] = p; }
    }
}

#ifndef EN_GLA
#define EN_GLA 1
#endif
#ifndef EN_ATT
#define EN_ATT 1
#endif
#ifndef EN_XAT
#define EN_XAT 1
#endif
#ifndef EN_GEMM
#define EN_GEMM 1
#endif
#ifndef REP_INPROJ
#define REP_INPROJ(r) 1
#endif
#ifndef REP_N1024
#define REP_N1024 1
#endif
constexpr int NPHASE = 14;
struct Ctx {
    LAS unsigned char* lds; int wave, G, bx, gw, NGW;
    const float* const* in; float* out; unsigned char* ws;
};
#define WSP(off) ((bf16_t*)(c.ws + (off)))
#define XROW(m) ((m) < 16 * T ? c.in[I_XP] + (size_t)(m) * 1024 : c.in[I_XS] + (size_t)((m) - 16 * T) * 1024)
#define GEMM(EPI, e, Ap, lda_, Bp, ldb_, M_, N_, K_) do { pg8::Gemm g_{Ap, Bp, M_, N_, K_, lda_, ldb_}; pg8::StaticOrder S_; S_.init(M_, N_, c.G, c.bx); S_.rep = gemm_rep; \
        if (EN_GEMM) pg8::gemm_phase<EPI, pg8::StaticOrder, true, true>(c.lds, g_, S_, e); } while (0)

DI void rms_rows_to_bf16(const Ctx& c, int row0, int nrows, const float* __restrict__ w, bf16_t* __restrict__ dst, int lane, int wv, int nwv) {
    constexpr int NR = 4;
    for (int m0 = wv * NR; m0 < nrows; m0 += nwv * NR) {
        f32x4 v[NR][4]; float s[NR];
#pragma unroll
        for (int k = 0; k < NR; ++k) { const float* xr = XROW(row0 + m0 + k);
#pragma unroll
            for (int j = 0; j < 4; ++j) v[k][j] = ((const f32x4*)xr)[lane + 64 * j]; }
#pragma unroll
        for (int k = 0; k < NR; ++k) { s[k] = 0.f;
#pragma unroll
            for (int j = 0; j < 4; ++j) s[k] += (v[k][j].x * v[k][j].x + v[k][j].y * v[k][j].y) + (v[k][j].z * v[k][j].z + v[k][j].w * v[k][j].w); }
#pragma unroll
        for (int off = 1; off < 64; off <<= 1)
#pragma unroll
            for (int k = 0; k < NR; ++k) s[k] += __shfl_xor(s[k], off);
#pragma unroll
        for (int k = 0; k < NR; ++k) { const float rstd = rsqrtf(s[k] * (1.f / 1024.f) + EPS);
#pragma unroll
            for (int j = 0; j < 4; ++j) { const f32x4 g = ((const f32x4*)w)[lane + 64 * j]; u32x2 p; p.x = pk2(v[k][j].x * rstd * g.x, v[k][j].y * rstd * g.y); p.y = pk2(v[k][j].z * rstd * g.z, v[k][j].w * rstd * g.w);
                ((u32x2*)(dst + (size_t)(m0 + k) * 1024))[lane + 64 * j] = p; } }
    }
}
struct NormP { const bf16_t* Yb; const float* xp; const float* xs; float* out; const float* wpost; const float* wpre; bf16_t* Hb; int first; const bf16_t* Xin; bf16_t* Xout; };
DI void norm_rows(const NormP& P, int row0, int nrows, int wv, int nwv, int lane) {
    constexpr int NR = 4;
    for (int i0 = wv * NR; i0 < nrows; i0 += nwv * NR) {
        const int m0 = row0 + i0;
        u32x2 yp[NR][4]; f32x4 bs[NR][4];
#pragma unroll
        for (int k = 0; k < NR; ++k) { const int m = m0 + k; const float* base = P.first ? (m < 16 * T ? P.xp + (size_t)m * 1024 : P.xs + (size_t)(m - 16 * T) * 1024) : P.out + (size_t)m * 1024;
#pragma unroll
            for (int j = 0; j < 4; ++j) { yp[k][j] = ((const u32x2*)(P.Yb + (size_t)m * 1024))[lane + 64 * j]; bs[k][j] = ((const f32x4*)base)[lane + 64 * j]; } }
        float s[NR];
#pragma unroll
        for (int k = 0; k < NR; ++k) { s[k] = 0.f;
#pragma unroll
            for (int j = 0; j < 4; ++j) { const float a0 = bf_lo(yp[k][j].x), a1 = bf_hi(yp[k][j].x), a2 = bf_lo(yp[k][j].y), a3 = bf_hi(yp[k][j].y); s[k] += (a0 * a0 + a1 * a1) + (a2 * a2 + a3 * a3); } }
#pragma unroll
        for (int off = 1; off < 64; off <<= 1)
#pragma unroll
            for (int k = 0; k < NR; ++k) s[k] += __shfl_xor(s[k], off);
        float s2[NR];
#pragma unroll
        for (int k = 0; k < NR; ++k) { const int m = m0 + k; const float rstd = rsqrtf(s[k] * (1.f / 1024.f) + EPS); s2[k] = 0.f;
#pragma unroll
            for (int j = 0; j < 4; ++j) { const f32x4 g = ((const f32x4*)P.wpost)[lane + 64 * j];
                f32x4 y; y.x = bf_lo(yp[k][j].x); y.y = bf_hi(yp[k][j].x); y.z = bf_lo(yp[k][j].y); y.w = bf_hi(yp[k][j].y);
                bs[k][j] = bs[k][j] + y * rstd * g; ((f32x4*)(P.out + (size_t)m * 1024))[lane + 64 * j] = bs[k][j];
                s2[k] += (bs[k][j].x * bs[k][j].x + bs[k][j].y * bs[k][j].y) + (bs[k][j].z * bs[k][j].z + bs[k][j].w * bs[k][j].w); } }
        if (P.Hb) {
#pragma unroll
            for (int off = 1; off < 64; off <<= 1)
#pragma unroll
                for (int k = 0; k < NR; ++k) s2[k] += __shfl_xor(s2[k], off);
#pragma unroll
            for (int k = 0; k < NR; ++k) { const int m = m0 + k; const float rstd2 = rsqrtf(s2[k] * (1.f / 1024.f) + EPS);
#pragma unroll
                for (int j = 0; j < 4; ++j) { const f32x4 g = ((const f32x4*)P.wpre)[lane + 64 * j]; u32x2 p; p.x = pk2(bs[k][j].x * rstd2 * g.x, bs[k][j].y * rstd2 * g.y); p.y = pk2(bs[k][j].z * rstd2 * g.z, bs[k][j].w * rstd2 * g.w);
                    ((u32x2*)(P.Hb + (size_t)m * 1024))[lane + 64 * j] = p; } }
        }
    }
}
template <int MODE>
struct EpiStoreNorm {
    static constexpr bool FIRST = MODE == 0, XOUT = MODE != 2, HOUT = MODE != 2;
    static constexpr bool PERM = true, AFTER_DRAIN = false, DEFER = true;
    bf16_t* O; unsigned* cnt; NormP P;
    DI void operator()(const f32x4 (&acc)[2][2][4][2], const pg8::Unit& u, int wr, int wc, int fr, int fq) const {
        const __amdgpu_buffer_rsrc_t rs = __builtin_amdgcn_make_buffer_rsrc(O, 0, MTOT * 1024 * 2, 0x00020000);
        const int row0 = u.pm * 256 + wr * 64 + fr, col0 = u.pn * 256 + wc * 32 + 8 * fq;
#pragma unroll
        for (int ai = 0; ai < 2; ++ai)
#pragma unroll
            for (int m = 0; m < 4; ++m) { const unsigned off = (unsigned)(((row0 + ai * 128 + m * 16) * 1024 + col0) * 2);
#pragma unroll
                for (int bj = 0; bj < 2; ++bj) { const f32x4 v0 = acc[ai][bj][m][0], v1 = acc[ai][bj][m][1];
                    u32x4 w; w.x = pk2(v0[0], v0[1]); w.y = pk2(v0[2], v0[3]); w.z = pk2(v1[0], v1[1]); w.w = pk2(v1[2], v1[3]);
                    __builtin_amdgcn_raw_buffer_store_b128(w, rs, off + bj * 256, 0, 16); } }
        asm volatile("s_waitcnt vmcnt(0)" ::: "memory");
        __builtin_amdgcn_s_barrier();
        if (threadIdx.x == 0) __hip_atomic_fetch_add(cnt + 16 * u.pm, 1u, __ATOMIC_RELAXED, __HIP_MEMORY_SCOPE_AGENT);
        if (!stagger()) normpass(u);
    }
    DI bool stagger() const { return ((blockIdx.x >> 3) & 1) != 0; }
    DI void deferred(const pg8::Unit& u) const { if (stagger()) normpass(u); }
    DI void normpass(const pg8::Unit& u) const {
        const int tid = threadIdx.x, lane = tid & 63;
        const int mrow = u.pm * 256 + u.pn * 64 + (tid >> 6) * 8;
        constexpr int NR = 4;
        f32x4 bs[NR][4];
#define NE_LOAD(m, dst) do { if constexpr (FIRST) { const float* b_ = (m) < 16 * T ? P.xp + (size_t)(m) * 1024 : P.xs + (size_t)((m) - 16 * T) * 1024; \
            _Pragma("unroll") for (int j = 0; j < 4; ++j) dst[j] = ((const f32x4*)b_)[lane + 64 * j]; } \
        else { _Pragma("unroll") for (int j = 0; j < 4; ++j) { const u32x2 p_ = ((const u32x2*)(P.Xin + (size_t)(m) * 1024))[lane + 64 * j]; \
            dst[j].x = bf_lo(p_.x); dst[j].y = bf_hi(p_.x); dst[j].z = bf_lo(p_.y); dst[j].w = bf_hi(p_.y); } } } while (0)
#pragma unroll
        for (int k = 0; k < NR; ++k) NE_LOAD(mrow + k, bs[k]);
        f32x4 gpost[4];
#pragma unroll
        for (int j = 0; j < 4; ++j) gpost[j] = ((const f32x4*)P.wpost)[lane + 64 * j];
        asm volatile("s_waitcnt vmcnt(0)" ::: "memory");
        if (tid == 0) { unsigned* cw = cnt + 16 * u.pm;
            unsigned sp = 0;
            while (__hip_atomic_load(cw, __ATOMIC_RELAXED, __HIP_MEMORY_SCOPE_AGENT) < 4u) { __builtin_amdgcn_s_sleep(1); if (++sp > (1u << 22)) break; }
            __builtin_amdgcn_fence(__ATOMIC_ACQUIRE, "agent"); asm volatile("s_waitcnt vmcnt(0)" ::: "memory"); }
        __builtin_amdgcn_s_barrier();
        asm volatile("" ::: "memory");
#pragma unroll
        for (int pass = 0; pass < 2; ++pass) {
            const int mr = mrow + 4 * pass;
            if (pass == 1) {
#pragma unroll
                for (int k = 0; k < NR; ++k) NE_LOAD(mr + k, bs[k]);
            }
            u32x2 yp[NR][4];
#pragma unroll
            for (int k = 0; k < NR; ++k)
#pragma unroll
                for (int j = 0; j < 4; ++j) yp[k][j] = ((const u32x2*)(P.Yb + (size_t)(mr + k) * 1024))[lane + 64 * j];
            float s1[NR];
#pragma unroll
            for (int k = 0; k < NR; ++k) { s1[k] = 0.f;
#pragma unroll
                for (int j = 0; j < 4; ++j) { const float a0 = bf_lo(yp[k][j].x), a1 = bf_hi(yp[k][j].x), a2 = bf_lo(yp[k][j].y), a3 = bf_hi(yp[k][j].y); s1[k] += (a0 * a0 + a1 * a1) + (a2 * a2 + a3 * a3); } }
#pragma unroll
            for (int off = 1; off < 64; off <<= 1)
#pragma unroll
                for (int k = 0; k < NR; ++k) s1[k] += __shfl_xor(s1[k], off);
            float s2[NR];
#pragma unroll
            for (int k = 0; k < NR; ++k) { const int m = mr + k; const float rstd = rsqrtf(s1[k] * (1.f / 1024.f) + EPS); s2[k] = 0.f;
#pragma unroll
                for (int j = 0; j < 4; ++j) { f32x4 y; y.x = bf_lo(yp[k][j].x); y.y = bf_hi(yp[k][j].x); y.z = bf_lo(yp[k][j].y); y.w = bf_hi(yp[k][j].y);
                    bs[k][j] = bs[k][j] + y * rstd * gpost[j];
                    if constexpr (XOUT) { u32x2 q; q.x = pk2(bs[k][j].x, bs[k][j].y); q.y = pk2(bs[k][j].z, bs[k][j].w); ((u32x2*)(P.Xout + (size_t)m * 1024))[lane + 64 * j] = q;
                        bs[k][j].x = bf_lo(q.x); bs[k][j].y = bf_hi(q.x); bs[k][j].z = bf_lo(q.y); bs[k][j].w = bf_hi(q.y); }
                    else ((f32x4*)(P.out + (size_t)m * 1024))[lane + 64 * j] = bs[k][j];
                    s2[k] += (bs[k][j].x * bs[k][j].x + bs[k][j].y * bs[k][j].y) + (bs[k][j].z * bs[k][j].z + bs[k][j].w * bs[k][j].w); } }
            if constexpr (HOUT) {
#pragma unroll
                for (int off = 1; off < 64; off <<= 1)
#pragma unroll
                    for (int k = 0; k < NR; ++k) s2[k] += __shfl_xor(s2[k], off);
#pragma unroll
                for (int k = 0; k < NR; ++k) { const int m = mr + k; const float rstd2 = rsqrtf(s2[k] * (1.f / 1024.f) + EPS);
#pragma unroll
                    for (int j = 0; j < 4; ++j) { const f32x4 gp = ((const f32x4*)P.wpre)[lane + 64 * j]; u32x2 p; p.x = pk2(bs[k][j].x * rstd2 * gp.x, bs[k][j].y * rstd2 * gp.y); p.y = pk2(bs[k][j].z * rstd2 * gp.z, bs[k][j].w * rstd2 * gp.w);
                        ((u32x2*)(P.Hb + (size_t)m * 1024))[lane + 64 * j] = p; } }
            }
        }
#undef NE_LOAD
        asm volatile("s_waitcnt vmcnt(0) lgkmcnt(0)" ::: "memory");
    }
};


template <int MODE>
struct EpiNormReg {
    static constexpr bool FIRST = MODE == 0, HOUT = MODE != 2;
    static constexpr int MB = FIRST ? 2 : 4;
    static constexpr bool PERM = true, AFTER_DRAIN = false, DEFER = false;
    const float* xp; const float* xs; const bf16_t* Xin; bf16_t* Xout; float* outf; bf16_t* Hb; const float* wpost; const float* wpre;
    float* xb1; unsigned* cnt1; float* xb2; unsigned* cnt2; PG8_LAS unsigned char* tl;
    DI void stats(const f32x4 (&v)[2][2][4][2], const pg8::Unit& u, int wr, int wc, int fr, int fq, float* xb, unsigned* cnt) const {
        PG8_LAS float* Pt = (PG8_LAS float*)tl; PG8_LAS float* St = (PG8_LAS float*)(tl + 4096);
        const int tid = threadIdx.x, wid = tid >> 6, lane = tid & 63;
#pragma unroll
        for (int ai = 0; ai < 2; ++ai)
#pragma unroll
            for (int m = 0; m < 4; ++m) { float q = 0.f;
#pragma unroll
                for (int bj = 0; bj < 2; ++bj)
#pragma unroll
                    for (int n = 0; n < 2; ++n) { const f32x4 x = v[ai][bj][m][n]; q += (x[0] * x[0] + x[1] * x[1]) + (x[2] * x[2] + x[3] * x[3]); }
                q += __shfl_xor(q, 16); q += __shfl_xor(q, 32);
                if (fq == 0) Pt[(ai * 128 + wr * 64 + m * 16 + fr) * 4 + wc] = q; }
        asm volatile("s_waitcnt lgkmcnt(0)" ::: "memory"); __builtin_amdgcn_s_barrier(); asm volatile("" ::: "memory");
        if (tid < 256) { const f32x4 p = *(const PG8_LAS f32x4*)(Pt + tid * 4);
            __hip_atomic_store(xb + (size_t)(u.pm * 256 + tid) * 4 + u.pn, (p[0] + p[1]) + (p[2] + p[3]), __ATOMIC_RELAXED, __HIP_MEMORY_SCOPE_AGENT);
            asm volatile("s_waitcnt vmcnt(0)" ::: "memory");
            if (lane == 0) __hip_atomic_fetch_add(cnt + 16 * u.pm, 1u, __ATOMIC_RELAXED, __HIP_MEMORY_SCOPE_AGENT); }
        if (wid == 0) { unsigned sp = 0;
            while ((unsigned)__builtin_amdgcn_readfirstlane(__hip_atomic_load(cnt + 16 * u.pm, __ATOMIC_RELAXED, __HIP_MEMORY_SCOPE_AGENT)) < 16u) { __builtin_amdgcn_s_sleep(1); if (++sp > (1u << 22)) break; }
            __builtin_amdgcn_fence(__ATOMIC_ACQUIRE, "agent"); }
        asm volatile("s_waitcnt vmcnt(0) lgkmcnt(0)" ::: "memory"); __builtin_amdgcn_s_barrier(); asm volatile("" ::: "memory");
        if (tid < 256) { const float* sl = xb + (size_t)(u.pm * 256 + tid) * 4; float t = 0.f;
#pragma unroll
            for (int k = 0; k < 4; ++k) t += __hip_atomic_load(sl + k, __ATOMIC_RELAXED, __HIP_MEMORY_SCOPE_AGENT);
            St[tid] = rsqrtf(t * (1.f / 1024.f) + EPS); }
        asm volatile("s_waitcnt lgkmcnt(0)" ::: "memory"); __builtin_amdgcn_s_barrier(); asm volatile("" ::: "memory");
    }
    DI void operator()(f32x4 (&acc)[2][2][4][2], const pg8::Unit& u, int wr, int wc, int fr, int fq) const {
        PG8_LAS float* St = (PG8_LAS float*)(tl + 4096);
        const int row0 = u.pm * 256 + wr * 64 + fr, col0 = u.pn * 256 + wc * 32 + 8 * fq;
        f32x4 gp[2][2];
#pragma unroll
        for (int bj = 0; bj < 2; ++bj) { gp[bj][0] = *(const f32x4*)(wpost + col0 + bj * 128); gp[bj][1] = *(const f32x4*)(wpost + col0 + bj * 128 + 4); }
        f32x4 bb[FIRST ? MB : 1][2][2]; u32x4 pk[FIRST ? 1 : MB][2];
#define NR_LOADS(ab_) do { const int ai = ((ab_) * MB) >> 2, m0 = ((ab_) * MB) & 3; \
        _Pragma("unroll") \
                    for (int mm = 0; mm < MB; ++mm) { const int m = m0 + mm; const int row = u.pm * 256 + ai * 128 + wr * 64 + m * 16 + fr; \
        _Pragma("unroll") \
                        for (int bj = 0; bj < 2; ++bj) { const int col = col0 + bj * 128; \
                            if constexpr (FIRST) { const float* bp = (row < 16 * T ? xp + (size_t)row * 1024 : xs + (size_t)(row - 16 * T) * 1024) + col; bb[mm][bj][0] = *(const f32x4*)bp; bb[mm][bj][1] = *(const f32x4*)(bp + 4); } \
                            else pk[mm][bj] = *(const u32x4*)(Xin + (size_t)row * 1024 + col); } } \
        } while (0)
        NR_LOADS(0);
        stats(acc, u, wr, wc, fr, fq, xb1, cnt1);
#pragma unroll
        for (int ab = 0; ab < 8 / MB; ++ab) { const int ai = (ab * MB) >> 2, m0 = (ab * MB) & 3;
            if (ab > 0) NR_LOADS(ab);
            asm volatile("" ::: "memory");
#pragma unroll
            for (int mm = 0; mm < MB; ++mm) { const int m = m0 + mm; const int rl = ai * 128 + wr * 64 + m * 16 + fr, row = u.pm * 256 + rl; const float rstd = St[rl];
#pragma unroll
                for (int bj = 0; bj < 2; ++bj) { const int col = col0 + bj * 128;
                    f32x4 b0, b1;
                    if constexpr (FIRST) { b0 = bb[mm][bj][0]; b1 = bb[mm][bj][1]; }
                    else { const u32x4 p = pk[mm][bj]; b0 = (f32x4){bf_lo(p.x), bf_hi(p.x), bf_lo(p.y), bf_hi(p.y)}; b1 = (f32x4){bf_lo(p.z), bf_hi(p.z), bf_lo(p.w), bf_hi(p.w)}; }
                    f32x4 v0 = b0 + acc[ai][bj][m][0] * rstd * gp[bj][0], v1 = b1 + acc[ai][bj][m][1] * rstd * gp[bj][1];
                    if constexpr (MODE == 2) { float* op = outf + (size_t)row * 1024 + col; *(f32x4*)op = v0; *(f32x4*)(op + 4) = v1; }
                    else { u32x4 w; w.x = pk2(v0[0], v0[1]); w.y = pk2(v0[2], v0[3]); w.z = pk2(v1[0], v1[1]); w.w = pk2(v1[2], v1[3]);
                        *(u32x4*)(Xout + (size_t)row * 1024 + col) = w;
                        v0 = (f32x4){bf_lo(w.x), bf_hi(w.x), bf_lo(w.y), bf_hi(w.y)}; v1 = (f32x4){bf_lo(w.z), bf_hi(w.z), bf_lo(w.w), bf_hi(w.w)}; }
                    acc[ai][bj][m][0] = v0; acc[ai][bj][m][1] = v1; } }
            asm volatile("" ::: "memory");
        }
#undef NR_LOADS
        if constexpr (HOUT) {
#pragma unroll
            for (int bj = 0; bj < 2; ++bj) { gp[bj][0] = *(const f32x4*)(wpre + col0 + bj * 128); gp[bj][1] = *(const f32x4*)(wpre + col0 + bj * 128 + 4); }
            stats(acc, u, wr, wc, fr, fq, xb2, cnt2);
#pragma unroll
            for (int ai = 0; ai < 2; ++ai)
#pragma unroll
                for (int m = 0; m < 4; ++m) { const int rl = ai * 128 + wr * 64 + m * 16 + fr, row = u.pm * 256 + rl; const float rstd = St[rl];
#pragma unroll
                    for (int bj = 0; bj < 2; ++bj) { const int col = col0 + bj * 128;
                        const f32x4 v0 = acc[ai][bj][m][0] * rstd * gp[bj][0], v1 = acc[ai][bj][m][1] * rstd * gp[bj][1];
                        u32x4 w; w.x = pk2(v0[0], v0[1]); w.y = pk2(v0[2], v0[3]); w.z = pk2(v1[0], v1[1]); w.w = pk2(v1[2], v1[3]);
                        *(u32x4*)(Hb + (size_t)row * 1024 + col) = w; } }
        }
    }
};
DI void ph_prologue(const Ctx& c) {
    const int tid = tid_opaque(); const int gw = c.gw, NGW = c.NGW, lane = tid & 63;
    LAS float* scr = (LAS float*)(c.lds + c.wave * 16384);
    const float* w_in = c.in[I_W_IN];
    bf16_t* Win_t = WSP(WS_WIN);
    transpose_seg(w_in, 1024, 6688, 0, 1024, Win_t, 0, 0, 1.f, scr, gw, NGW, lane);
    transpose_seg(w_in, 1024, 6688, 2048, 1024, Win_t, 1024, 0, 1.f, scr, gw, NGW, lane);
    transpose_seg(w_in, 1024, 6688, 3104, 1536, Win_t, 2048, 0, 1.f, scr, gw, NGW, lane);
    transpose_seg(w_in, 1024, 6688, 3072, 32, Win_t, 3584, 0, 1.f, scr, gw, NGW, lane);
    transpose_seg(w_in, 1024, 6688, 4640, 2048, Win_t, 3840, 0, 1.f, scr, gw, NGW, lane);
    transpose_seg(w_in, 1024, 6688, 1024, 1024, WSP(WS_WGV), 0, 0, 1.f, scr, gw, NGW, lane);
    for (int i = c.bx * 512 + tid; i < 224 * 1024 / 8; i += c.G * 512) ((u32x4*)(Win_t + (size_t)3616 * 1024))[i] = (u32x4){0u, 0u, 0u, 0u};
    transpose_seg(c.in[I_W_BR_GLA], 1024, 1024, 0, 1024, WSP(WS_WA), 0, 0, 1.f, scr, gw, NGW, lane);
    transpose_seg(c.in[I_W_BR_ATT], 1024, 1024, 0, 1024, WSP(WS_WB), 0, 0, 1.f, scr, gw, NGW, lane);
    transpose_seg(c.in[I_W_OUT], 1024, 1024, 0, 1024, WSP(WS_WOUT), 0, 0, 1.f, scr, gw, NGW, lane);
    transpose_seg(c.in[I_X_WQ], 1024, 1024, 0, 1024, WSP(WS_WQ), 0, 0, 0.0625f, scr, gw, NGW, lane);
    transpose_seg(c.in[I_X_WKV], 1024, 2048, 0, 2048, WSP(WS_WKV), 0, 0, 1.f, scr, gw, NGW, lane);
    transpose_seg(c.in[I_X_WO], 1024, 1024, 0, 1024, WSP(WS_WO), 0, 0, 1.f, scr, gw, NGW, lane);
    transpose_seg(c.in[I_FFN_WI], 1024, 2 * DFF, 0, 2 * DFF, WSP(WS_WI), 0, 1, 1.f, scr, gw, NGW, lane);
    transpose_seg(c.in[I_FFN_WO], DFF, 1024, 0, 1024, WSP(WS_WO2), 0, 0, 1.f, scr, gw, NGW, lane);
    float* TAB = (float*)(c.ws + WS_TAB);
    for (int i = c.bx * 512 + tid; i < 64 * 32; i += c.G * 512) { const int pos = i >> 5, f = i & 31;
        const float inv = powf(10000.f, -(float)(2 * f) / 64.f); const float ang = (float)pos * inv;
        TAB[i] = cosf(ang); TAB[2048 + i] = sinf(ang); }
    bf16_t* MEMN = (bf16_t*)((char*)c.out + 64 * MiB);
    for (int m = gw; m < MMEM; m += NGW) { const float* mr = m < 16 * NMEM ? c.in[I_MP] + (size_t)m * 1024 : c.in[I_MS] + (size_t)(m - 16 * NMEM) * 1024;
        rms_row_to_bf16(mr, c.in[I_LN_MEM], MEMN + (size_t)m * 1024, lane); }
    rms_rows_to_bf16(c, 0, MR, c.in[I_LN_MIX_PRE], WSP(WS_XN), lane, gw, NGW);
}
DI void ph_inproj(const Ctx& c, int r, int gemm_rep) {
    { EpiProj e{WSP(WS_PROJ), WSP(WS_GATES) + (size_t)r * MR * 2048}; GEMM(EpiProj, e, WSP(WS_XN), 1024, WSP(WS_WIN), 1024, MR, N1, 1024); }
    { EpiStore e{WSP(WS_GVT), MR}; GEMM(EpiStore, e, WSP(WS_WGV), 1024, WSP(WS_XN), 1024, 1024, MR, 1024); }
}
DI void ph_memkv(const Ctx& c, int r, int gemm_rep) {
    bf16_t* MEMN = (bf16_t*)((char*)c.out + 64 * MiB) + (size_t)r * 2048 * 1024;
    int bxs = (c.bx + 64) % c.G;
#define GEMM_S(EPI, e, Ap, lda_, Bp, ldb_, M_, N_, K_) do { pg8::Gemm g_{Ap, Bp, M_, N_, K_, lda_, ldb_}; pg8::StaticOrder S_; S_.init(M_, N_, c.G, bxs); S_.rep = gemm_rep; \
        if (EN_GEMM) pg8::gemm_phase<EPI, pg8::StaticOrder, true, true>(c.lds, g_, S_, e); } while (0)
    { EpiStore e{WSP(WS_KMEM) + (size_t)r * 2048 * 1024, 1024}; GEMM_S(EpiStore, e, MEMN, 1024, WSP(WS_WKV), 1024, 2048, 1024, 1024); }
    bxs = (c.bx + 32) % c.G;
    { EpiStore e{WSP(WS_VTMEM) + (size_t)r * 2048, MMEM}; GEMM_S(EpiStore, e, WSP(WS_WKV) + (size_t)1024 * 1024, 1024, MEMN, 1024, 1024, 2048, 1024); }
#undef GEMM_S
}
DI void kprep_item(const Ctx& c, int bl, int ch, int lane) {
    const float* kn = c.in[I_KNORM]; const float* TAB = (const float*)(c.ws + WS_TAB);
    const int sub = lane >> 4, q = lane & 15, blk = q >> 3, fb = (q & 7) * 4;
    const f32x4 g1 = *(const f32x4*)(kn + 64 * blk + fb), g2 = *(const f32x4*)(kn + 64 * blk + 32 + fb);
    constexpr int NIT = 4;
    const int grp0 = (bl * T + ch * 256) * 2 / 4;
    for (int i0 = c.wave * NIT; i0 < 128; i0 += 8 * NIT) {
        u32x2 a[NIT], b[NIT]; bf16_t* pp[NIT]; int tt[NIT];
#pragma unroll
        for (int k = 0; k < NIT; ++k) { const int row = (grp0 + i0 + k) * 4 + sub; const int t = row >> 1, hd = row & 1; tt[k] = t & (T - 1);
            pp[k] = WSP(WS_PROJ) + (size_t)t * LDP + PC_AK + hd * 128 + 64 * blk + fb;
            a[k] = *(const u32x2*)pp[k]; b[k] = *(const u32x2*)(pp[k] + 32); }
#pragma unroll
        for (int k = 0; k < NIT; ++k) {
            float x1[4] = {bf_lo(a[k].x), bf_hi(a[k].x), bf_lo(a[k].y), bf_hi(a[k].y)}, x2[4] = {bf_lo(b[k].x), bf_hi(b[k].x), bf_lo(b[k].y), bf_hi(b[k].y)};
            float ss = (x1[0] * x1[0] + x1[1] * x1[1]) + (x1[2] * x1[2] + x1[3] * x1[3]) + (x2[0] * x2[0] + x2[1] * x2[1]) + (x2[2] * x2[2] + x2[3] * x2[3]);
            ss += __shfl_xor(ss, 1); ss += __shfl_xor(ss, 2); ss += __shfl_xor(ss, 4); ss += __shfl_xor(ss, 8);
            const float rstd = rsqrtf(ss * (1.f / 128.f) + EPS);
            const int pos = blk ? (tt[k] & 63) : (tt[k] >> 6);
            const f32x4 cs = *(const f32x4*)(TAB + pos * 32 + fb), sn = *(const f32x4*)(TAB + 2048 + pos * 32 + fb);
            float o1[4], o2[4];
#pragma unroll
            for (int x = 0; x < 4; ++x) { const float u = x1[x] * rstd * g1[x], v = x2[x] * rstd * g2[x]; o1[x] = u * cs[x] - v * sn[x]; o2[x] = v * cs[x] + u * sn[x]; }
            u32x2 w1, w2; w1.x = pk2(o1[0], o1[1]); w1.y = pk2(o1[2], o1[3]); w2.x = pk2(o2[0], o2[1]); w2.y = pk2(o2[2], o2[3]);
            *(u32x2*)pp[k] = w1; *(u32x2*)(pp[k] + 32) = w2; }
    }
}
DI void combine_item(const Ctx& c, int r, int bl, int tch, int lane) {
    const float* gn = c.in[I_GLA_NORM];
    bf16_t* OFB = WSP(WS_OFB); bf16_t* PROJ = WSP(WS_PROJ); bf16_t* GLA_O = (bf16_t*)c.out;
    const f32x4 g = *(const f32x4*)(gn + lane * 4);
    constexpr int NIT = 8;
    const int base = (bl * T + tch * 64) * 4;
    for (int i0 = c.wave * NIT; i0 < 256; i0 += 8 * NIT) {
        u32x2 a[NIT], b[NIT], rr[NIT];
#pragma unroll
        for (int k = 0; k < NIT; ++k) { const int it = base + i0 + k, t = it >> 2, h = it & 3;
            a[k] = *(const u32x2*)(OFB + (size_t)t * 1024 + h * 256 + lane * 4); b[k] = *(const u32x2*)(OFB + (size_t)(MR + t) * 1024 + h * 256 + lane * 4);
            rr[k] = *(const u32x2*)(PROJ + (size_t)t * LDP + PC_GR + h * 256 + lane * 4); }
        float o[NIT][4], ss[NIT];
#pragma unroll
        for (int k = 0; k < NIT; ++k) { o[k][0] = bf_lo(a[k].x) + bf_lo(b[k].x); o[k][1] = bf_hi(a[k].x) + bf_hi(b[k].x); o[k][2] = bf_lo(a[k].y) + bf_lo(b[k].y); o[k][3] = bf_hi(a[k].y) + bf_hi(b[k].y);
            ss[k] = (o[k][0] * o[k][0] + o[k][1] * o[k][1]) + (o[k][2] * o[k][2] + o[k][3] * o[k][3]); }
#pragma unroll
        for (int off = 1; off < 64; off <<= 1)
#pragma unroll
            for (int k = 0; k < NIT; ++k) ss[k] += __shfl_xor(ss[k], off);
#pragma unroll
        for (int k = 0; k < NIT; ++k) { const int it = base + i0 + k, t = it >> 2, h = it & 3;
            const float rstd = rsqrtf(ss[k] * (1.f / 256.f) + EPS);
            const float rv[4] = {bf_lo(rr[k].x), bf_hi(rr[k].x), bf_lo(rr[k].y), bf_hi(rr[k].y)};
            float v[4];
#pragma unroll
            for (int j = 0; j < 4; ++j) v[j] = o[k][j] * rstd * g[j] * (rv[j] * sigmoidf_(rv[j]));
            u32x2 w; w.x = pk2(v[0], v[1]); w.y = pk2(v[2], v[3]);
            *(u32x2*)(GLA_O + (size_t)(r * MR + t) * 1024 + h * 256 + lane * 4) = w; }
    }
}
DI void ph_mixers(const Ctx& c, int r) {
    const int tid = tid_opaque();
    LAS int* qslot = (LAS int*)(c.lds + LDS_MISC);
    unsigned* CTL = (unsigned*)(c.ws + WS_CTL);
    bf16_t* PROJ = WSP(WS_PROJ); bf16_t* ATT_O = (bf16_t*)c.out + (size_t)MTOT * 1024;
    for (;;) {
        __syncthreads();
        if (tid == 0) *qslot = (int)atomicAdd(CTL + 64 * (1 + 2 * r), 1u);
        __syncthreads();
        const int it = *qslot;
        if (it >= 64) break;
        const int bl = it >> 3, h = (it >> 1) & 3, dir = it & 1;
        if (EN_GLA) gla::item((LAS char*)c.lds, PROJ, WSP(WS_GVT), WSP(WS_OFB) + (size_t)dir * MR * 1024, c.in[dir ? I_WA_B : I_WA_F], c.in[dir ? I_BA_B : I_BA_F], bl, h, dir);
        asm volatile("s_waitcnt vmcnt(0)" ::: "memory");
        __syncthreads();
        if (tid == 0) { __builtin_amdgcn_fence(__ATOMIC_RELEASE, "agent"); asm volatile("s_waitcnt vmcnt(0)" ::: "memory");
            __hip_atomic_fetch_add(CTL + 1024 + r * 8 + bl, 1u, __ATOMIC_RELAXED, __HIP_MEMORY_SCOPE_AGENT); }
    }
    for (;;) {
        __syncthreads();
        if (tid == 0) *qslot = (int)atomicAdd(CTL + 64 * (10 + r), 1u);
        __syncthreads();
        const int it = *qslot;
        if (it >= 64) break;
        kprep_item(c, it >> 3, it & 7, tid & 63);
        asm volatile("s_waitcnt vmcnt(0)" ::: "memory");
        __syncthreads();
        if (tid == 0) { __builtin_amdgcn_fence(__ATOMIC_RELEASE, "agent"); asm volatile("s_waitcnt vmcnt(0)" ::: "memory");
            __hip_atomic_fetch_add(CTL + 1088 + r * 8 + (it >> 3), 1u, __ATOMIC_RELAXED, __HIP_MEMORY_SCOPE_AGENT); }
    }
    const int myx = (int)((unsigned)__builtin_amdgcn_s_getreg((3 << 11) | 20) & 7u);
    for (int kq = 0; kq < 8; ++kq) {
        const int qx = (myx + kq) & 7;
        for (;;) {
            __syncthreads();
            if (tid == 0) *qslot = (int)atomicAdd(CTL + 2048 + (r * 8 + qx) * 64, 1u);
            __syncthreads();
            const int uq = *qslot;
            if (uq >= 64) break;
            const int u = qx * 64 + uq;
            const int bl = u >> 6, hq = (u >> 3) & 7, qb = u & 7, kvh = hq >> 2;
            if (tid == 0) { while (__hip_atomic_load(CTL + 1088 + r * 8 + bl, __ATOMIC_RELAXED, __HIP_MEMORY_SCOPE_AGENT) < 8u) __builtin_amdgcn_s_sleep(2);
                __builtin_amdgcn_fence(__ATOMIC_ACQUIRE, "agent"); asm volatile("s_waitcnt vmcnt(0)" ::: "memory"); }
            __syncthreads();
            const bf16_t* pb = PROJ + (size_t)(bl * T) * LDP;
            if (EN_ATT) att::attn_dense_body<LDP, LDP, 1024>(pb + (size_t)(qb * 256) * LDP + PC_AQ + hq * 128, pb + PC_AK + kvh * 128, pb + PC_AV + kvh * 128,
                                                 ATT_O + (size_t)(r * MR + bl * T + qb * 256) * 1024 + hq * 128, T, (LAS char*)c.lds, c.in[I_QNORM], (const float*)(c.ws + WS_TAB), qb * 256);
        }
    }
    const int lane = tid & 63;
    const int nxn = (r < 2 ? 64 : 0), nlight = nxn + 256;
    for (;;) {
        __syncthreads();
        if (tid == 0) *qslot = (int)atomicAdd(CTL + 64 * (7 + r), 1u);
        __syncthreads();
        const int it = *qslot;
        if (it >= nlight) break;
        if (it < nxn) {
            rms_rows_to_bf16(c, (r + 1) * MR + it * 256, 256, c.in[I_LN_MIX_PRE], WSP(WS_XN) + (size_t)it * 256 * 1024, lane, c.wave, 8);
        } else { const int ci = it - nxn, bl = ci >> 5, tch = ci & 31;
            if (tid == 0) { while (__hip_atomic_load(CTL + 1024 + r * 8 + bl, __ATOMIC_RELAXED, __HIP_MEMORY_SCOPE_AGENT) < 8u) __builtin_amdgcn_s_sleep(4);
                __builtin_amdgcn_fence(__ATOMIC_ACQUIRE, "agent"); asm volatile("s_waitcnt vmcnt(0)" ::: "memory"); }
            __syncthreads();
            combine_item(c, r, bl, tch, lane);
        }
    }
}
DI void ph_cross(const Ctx& c) {
    for (int u = c.bx; u < NBATCH * 4 * 8; u += c.G) { const int b = u >> 5, hx = (u >> 3) & 3, qb = u & 7;
        if (EN_XAT) xat::unit((LAS char*)c.lds, WSP(WS_QX), WSP(WS_KMEM), WSP(WS_VTMEM), WSP(WS_OX), b, hx, qb); }
}

#define XB_TMO      128
#define XB_XCNT(j)  (256  + 64 * (j))
#define XB_XSUB(j)  (1280 + 64 * (j))
#define XB_XGEN(j)  (2304 + 64 * (j))
#define XB_TOP      3328
#define XB_TOPGEN   3392
#define XCD_BAR_WORDS 3456
#define XB_SPIN_CAP (1u << 22)
DI unsigned xb_ld(unsigned* p)              { return __hip_atomic_load(p, __ATOMIC_RELAXED, __HIP_MEMORY_SCOPE_AGENT); }
DI unsigned xb_add(unsigned* p, unsigned v) { return __hip_atomic_fetch_add(p, v, __ATOMIC_RELAXED, __HIP_MEMORY_SCOPE_AGENT); }
DI unsigned xb_xcc_id() { return (unsigned)__builtin_amdgcn_s_getreg((3 << 11) | 20) & 0xFu; }
#define XB_SPIN(cond, bar) do { unsigned _sp = 0; while (cond) { __builtin_amdgcn_s_sleep(1); \
    if ((++_sp & 255u) == 0u) { if (xb_ld(&(bar)[XB_TMO])) break; if (_sp > XB_SPIN_CAP) { atomicAdd(&(bar)[XB_TMO], 1u); break; } } } } while (0)
struct XcdBarrier { unsigned* bar; unsigned x; volatile LAS unsigned* st; };
DI XcdBarrier xcd_barrier_post(unsigned* bar, volatile LAS unsigned* st) {
    XcdBarrier b; b.bar = bar; b.x = xb_xcc_id(); b.st = st;
    if (threadIdx.x == 0) (void)xb_add(&bar[XB_XCNT(b.x)], 1u);
    return b;
}
DI void xcd_barrier_complete(unsigned* bar, unsigned x, unsigned& nloc, unsigned& nx) {
    const unsigned G = gridDim.x * gridDim.y * gridDim.z;
    unsigned sum, cnt, mine, sp = 0u;
    for (;;) {
        sum = 0u; cnt = 0u; mine = 0u;
#pragma unroll
        for (unsigned j = 0; j < 16; ++j) { const unsigned c = xb_ld(&bar[XB_XCNT(j)]); sum += c; cnt += (c > 0u) ? 1u : 0u; mine = (j == x) ? c : mine; }
        if (sum == G) break;
        __builtin_amdgcn_s_sleep(1);
        if ((++sp & 255u) == 0u) { if (xb_ld(&bar[XB_TMO])) break; if (sp > XB_SPIN_CAP) { atomicAdd(&bar[XB_TMO], 1u); break; } }
    }
    nloc = mine > 0u ? mine : 1u; nx = cnt > 0u ? cnt : 1u;
}
DI void xcd_barrier(const XcdBarrier& b) {
    asm volatile("s_waitcnt vmcnt(0)" ::: "memory");
    __syncthreads();
    if (threadIdx.x == 0) {
        unsigned* bar = b.bar;
        __builtin_amdgcn_s_waitcnt(0);
        unsigned nloc = b.st[0], nx = b.st[1];
        if (nloc == 0u) { xcd_barrier_complete(bar, b.x, nloc, nx); b.st[0] = nloc; b.st[1] = nx; }
        const unsigned old = xb_add(&bar[XB_XSUB(b.x)], 1u);
        const unsigned gen = old / nloc;
        if (old + 1u == (gen + 1u) * nloc) {
            __builtin_amdgcn_fence(__ATOMIC_RELEASE, "agent");
            asm volatile("s_waitcnt vmcnt(0)" ::: "memory");
            const unsigned og = xb_add(&bar[XB_TOP], 1u);
            const unsigned tg = og / nx;
            if (og + 1u == (tg + 1u) * nx) xb_add(&bar[XB_TOPGEN], 1u);
            else XB_SPIN(xb_ld(&bar[XB_TOPGEN]) == tg, bar);
            __builtin_amdgcn_fence(__ATOMIC_ACQUIRE, "agent");
            xb_add(&bar[XB_XGEN(b.x)], 1u);
            asm volatile("s_waitcnt vmcnt(0)" ::: "memory");
        } else {
            XB_SPIN(xb_ld(&bar[XB_XGEN(b.x)]) == gen, bar);
            __builtin_amdgcn_fence(__ATOMIC_ACQUIRE, "agent");
            asm volatile("s_waitcnt vmcnt(0)" ::: "memory");
        }
    }
    __syncthreads();
}
DI void grid_bar(unsigned* ctr, unsigned target) {
    asm volatile("s_waitcnt vmcnt(0)" ::: "memory");
    __syncthreads();
    if (threadIdx.x == 0) {
        __builtin_amdgcn_fence(__ATOMIC_RELEASE, "agent");
        asm volatile("s_waitcnt vmcnt(0)" ::: "memory");
        __hip_atomic_fetch_add(ctr, 1u, __ATOMIC_RELAXED, __HIP_MEMORY_SCOPE_AGENT);
        while (__hip_atomic_load(ctr, __ATOMIC_RELAXED, __HIP_MEMORY_SCOPE_AGENT) < target) __builtin_amdgcn_s_sleep(2);
        __builtin_amdgcn_fence(__ATOMIC_ACQUIRE, "agent");
        asm volatile("s_waitcnt vmcnt(0)" ::: "memory");
    }
    __syncthreads();
}
__global__ void __launch_bounds__(512) fwd(Args args) {
    extern __shared__ __attribute__((aligned(16))) unsigned char lds_raw[];
    Ctx c;
    c.lds = (LAS unsigned char*)lds_raw;
    c.wave = __builtin_amdgcn_readfirstlane(threadIdx.x >> 6);
    c.G = gridDim.x; c.bx = blockIdx.x; c.gw = c.bx * 8 + c.wave; c.NGW = c.G * 8;
    c.in = args.in; c.out = args.out; c.ws = args.ws;
    cg::grid_group grid = cg::this_grid();
    const int lo = args.ph_lo, hi = args.ph_hi;
    volatile LAS unsigned* xst = (volatile LAS unsigned*)(c.lds + LDS_MISC + 128);
    if (threadIdx.x < 2) xst[threadIdx.x] = 0u;
    __syncthreads();
    XcdBarrier xbar; xbar.bar = (unsigned*)(c.ws + WS_CTL) + 4096; xbar.x = 0; xbar.st = xst;
    if (hi - lo > 1) xbar = xcd_barrier_post((unsigned*)(c.ws + WS_CTL) + 4096, xst);
    int gemm_rep = 1;
#define IN(k) (lo <= (k) && (k) < hi)
#define SEAM(k) do { if (IN(k) && IN((k) + 1)) { if (args.ph_hi < 0) grid.sync(); else xcd_barrier(xbar); } } while (0)
    if (IN(0)) ph_prologue(c);
    SEAM(0);
#define ROUND(r) \
    if (IN(1 + 2 * (r))) { ph_inproj(c, r, REP_INPROJ(r)); ph_memkv(c, r, REP_INPROJ(r)); } SEAM(1 + 2 * (r)); \
    if (IN(2 + 2 * (r))) ph_mixers(c, r); SEAM(2 + 2 * (r));
    ROUND(0) ROUND(1) ROUND(2)
    if (IN(7)) { EpiGate e{WSP(WS_GATES), 0}; GEMM(EpiGate, e, (bf16_t*)c.out, 1024, WSP(WS_WA), 1024, MTOT, 1024, 1024);
        asm volatile("s_waitcnt vmcnt(0)" ::: "memory"); __syncthreads();
        if (threadIdx.x == 0) { __builtin_amdgcn_fence(__ATOMIC_ACQUIRE, "agent"); asm volatile("s_waitcnt vmcnt(0)" ::: "memory"); }
        __syncthreads();
        EpiGate e2{WSP(WS_GATES), 1}; GEMM(EpiGate, e2, (bf16_t*)c.out + (size_t)MTOT * 1024, 1024, WSP(WS_WB), 1024, MTOT, 1024, 1024); }
    SEAM(7);
    bf16_t* XB1 = (bf16_t*)c.out; bf16_t* XB2 = WSP(408 * MiB); bf16_t* H3 = WSP(312 * MiB); bf16_t* Y2 = WSP(48 * MiB); bf16_t* Y3 = WSP(312 * MiB);
#define NREG(MODE_, cb, wpost_, wpre_, Hp, Xin_, Xout_) EpiNormReg<MODE_>{c.in[I_XP], c.in[I_XS], Xin_, Xout_, c.out, Hp, wpost_, wpre_, \
        (float*)(c.ws + WS_CTL + 131072), (unsigned*)(c.ws + WS_CTL) + (cb), (float*)((char*)c.out + 96 * MiB), (unsigned*)(c.ws + WS_CTL) + (cb) + 3072, (PG8_LAS unsigned char*)(c.lds + 131072 + 8192)}
    if (IN(8)) { EpiNormReg<0> e = NREG(0, 8192, c.in[I_LN_MIX_POST], c.in[I_LN_X_PRE], WSP(WS_H), nullptr, XB1); GEMM(EpiNormReg<0>, e, WSP(WS_GATES), 2048, WSP(WS_WOUT), 1024, MTOT, 1024, 1024); } SEAM(8);
    gemm_rep = REP_N1024; if (IN(9)) { EpiStore e{WSP(WS_QX), 1024}; GEMM(EpiStore, e, WSP(WS_H), 1024, WSP(WS_WQ), 1024, MTOT, 1024, 1024); } gemm_rep = 1; SEAM(9);
    if (IN(10)) ph_cross(c); SEAM(10);
    if (IN(11)) { EpiNormReg<1> e = NREG(1, 8192 + 6144, c.in[I_LN_X_POST], c.in[I_LN_FFN_PRE], H3, XB1, XB2); GEMM(EpiNormReg<1>, e, WSP(WS_OX), 1024, WSP(WS_WO), 1024, MTOT, 1024, 1024); } SEAM(11);
    if (IN(12)) { EpiSwiglu e{WSP(WS_ACT)}; GEMM(EpiSwiglu, e, H3, 1024, WSP(WS_WI), 1024, MTOT, 2 * DFF, 1024); } SEAM(12);
    if (IN(13)) { EpiNormReg<2> e = NREG(2, 8192 + 12288, c.in[I_LN_FFN_POST], nullptr, nullptr, XB2, nullptr); GEMM(EpiNormReg<2>, e, WSP(WS_ACT), DFF, WSP(WS_WO2), DFF, MTOT, 1024, DFF); }
}

#ifndef N_LAUNCH_MODE
#define N_LAUNCH_MODE 0
#endif
extern "C" void kernel_launch(void* const* d_in, const int* in_sizes, int n_in, void* d_out, int out_size, void* d_ws, size_t ws_size, hipStream_t stream) {
    static int grid = 0;
    if (grid == 0) {
        if (n_in != 27 || out_size != MTOT * 1024 || ws_size < WS_END) { fprintf(stderr, "kernel_launch: unexpected shapes: n_in %d out %d ws %zu (need %zu)\n", n_in, out_size, ws_size, (size_t)WS_END); grid = -1; return; }
        int dev = 0, cus = 0, per_cu = 0;
        hipGetDevice(&dev); hipDeviceGetAttribute(&cus, hipDeviceAttributeMultiprocessorCount, dev);
        if (hipFuncSetAttribute((const void*)fwd, hipFuncAttributeMaxDynamicSharedMemorySize, LDS_BYTES) != hipSuccess) { fprintf(stderr, "kernel_launch: hipFuncSetAttribute failed\n"); grid = -1; return; }
        if (hipOccupancyMaxActiveBlocksPerMultiprocessor(&per_cu, (const void*)fwd, 512, LDS_BYTES) != hipSuccess || per_cu < 1) { fprintf(stderr, "kernel_launch: occupancy query says %d\n", per_cu); per_cu = 1; }
        (void)hipGetLastError();
        grid = cus * 1;
    }
    if (grid < 0) return;
    hipMemsetAsync((char*)d_ws + WS_CTL, 0, 131072, stream);
    Args a{};
    for (int i = 0; i < 27; ++i) a.in[i] = (const float*)d_in[i];
    a.out = (float*)d_out; a.ws = (unsigned char*)d_ws;
#if N_LAUNCH_MODE == 0
    a.ph_lo = 0; a.ph_hi = NPHASE;
    void* kargs[] = {&a};
    hipError_t e = hipLaunchCooperativeKernel((const void*)fwd, dim3(grid), dim3(512), kargs, LDS_BYTES, stream);
    if (e != hipSuccess) fprintf(stderr, "cooperative launch failed: %s (grid %d)\n", hipGetErrorString(e), grid);
#else
    for (int ph = 0; ph < NPHASE; ++ph) { a.ph_lo = ph; a.ph_hi = ph + 1; hipLaunchKernelGGL(fwd, dim3(grid), dim3(512), LDS_BYTES, stream, a); }
    hipError_t e = hipPeekAtLastError();
    if (e != hipSuccess) fprintf(stderr, "launch failed: %s\n", hipGetErrorString(e));
#endif
}
```
